# Optimizing an MI355X kernel written in HIP

```python
import math
import jax, jax.numpy as jnp
from jax import lax
import numpy as np

D_MODEL = 1024
BATCH = 8
SEQ = 4096
DEPTH = 2

HEAD_DIM = 64
N_HEADS_SB = 8
N_HEADS_FOX = 8
W_SB = N_HEADS_SB * HEAD_DIM
W_FOX = N_HEADS_FOX * HEAD_DIM
Q_BLOCK = 128
D_FF = 2816
N_EXPERTS = 8
TOP_K = 2
D_FF_EXPERT = 1408
N_DENSE = (DEPTH + 1) // 2
N_MOE = DEPTH // 2
RMS_EPS = 1e-6
PROJ_IN = 3 * W_SB + 3 * W_FOX + N_HEADS_FOX + 2 * D_MODEL

kernel_name = "hybrid_stickbreaking_fox_gated_moe"


def rmsnorm(x, g):
    x32 = x.astype(jnp.float32)
    y = x32 * lax.rsqrt(jnp.mean(x32 * x32, axis=-1, keepdims=True) + RMS_EPS)
    return (y * g.astype(jnp.float32)).astype(x.dtype)


def split_heads(t, n_heads):
    b, s, _ = t.shape
    return t.reshape(b, s, n_heads, HEAD_DIM).transpose(0, 2, 1, 3)


def merge_heads(t):
    b, h, s, d = t.shape
    return t.transpose(0, 2, 1, 3).reshape(b, s, h * d)


def stick_breaking_attention(q, k, v):
    seq = q.shape[2]
    scale = 1.0 / math.sqrt(HEAD_DIM)
    outs = []
    for i in range(seq // Q_BLOCK):
        t0 = i * Q_BLOCK
        kv_len = t0 + Q_BLOCK
        qb = q[:, :, t0:kv_len]
        kb = k[:, :, :kv_len]
        vb = v[:, :, :kv_len]
        z = jnp.einsum('bhqd,bhkd->bhqk', qb, kb).astype(jnp.float32) * scale
        q_pos = t0 + jnp.arange(Q_BLOCK)[:, None]
        k_pos = jnp.arange(kv_len)[None, :]
        mask = k_pos < q_pos
        log_beta = jax.nn.log_sigmoid(z)
        log_keep = jnp.where(mask, jax.nn.log_sigmoid(-z), 0.0)
        tail = lax.cumsum(log_keep, axis=log_keep.ndim - 1, reverse=True) - log_keep
        w = jnp.where(mask, jnp.exp(log_beta + tail), 0.0)
        outs.append(jnp.einsum('bhqk,bhkd->bhqd', w.astype(vb.dtype), vb))
    return jnp.concatenate(outs, axis=2)


def forgetting_attention(q, k, v, log_f):
    seq = q.shape[2]
    scale = 1.0 / math.sqrt(HEAD_DIM)
    cum_f = lax.cumsum(log_f, axis=log_f.ndim - 1)
    outs = []
    for i in range(seq // Q_BLOCK):
        t0 = i * Q_BLOCK
        kv_len = t0 + Q_BLOCK
        qb = q[:, :, t0:kv_len]
        kb = k[:, :, :kv_len]
        vb = v[:, :, :kv_len]
        z = jnp.einsum('bhqd,bhkd->bhqk', qb, kb).astype(jnp.float32) * scale
        decay = cum_f[:, :, t0:kv_len, None] - cum_f[:, :, None, :kv_len]
        q_pos = t0 + jnp.arange(Q_BLOCK)[:, None]
        k_pos = jnp.arange(kv_len)[None, :]
        logits = jnp.where(k_pos <= q_pos, z + decay, -jnp.inf)
        p = jax.nn.softmax(logits, axis=-1)
        outs.append(jnp.einsum('bhqk,bhkd->bhqd', p.astype(vb.dtype), vb))
    return jnp.concatenate(outs, axis=2)


def swiglu(h, w_gu, w_dn):
    gu = h @ w_gu
    g, u = jnp.split(gu, 2, axis=-1)
    return (jax.nn.silu(g) * u) @ w_dn


def moe_swiglu(h, w_router, w_gu_e, w_dn_e):
    logits = (h @ w_router).astype(jnp.float32)
    top_val, top_idx = lax.top_k(logits, TOP_K)
    top_w = jax.nn.softmax(top_val, axis=-1)
    combine = jnp.sum(jax.nn.one_hot(top_idx, N_EXPERTS, dtype=jnp.float32) * top_w[..., None], axis=-2)
    combine = combine.astype(h.dtype)
    out = jnp.zeros_like(h)
    for e in range(N_EXPERTS):
        out = out + combine[..., e:e + 1] * swiglu(h, w_gu_e[e], w_dn_e[e])
    return out


def setup_inputs(seed: int = 0) -> dict:
    key = jax.random.key(seed)
    ks = jax.random.split(key, 16)
    nrm = lambda k, shape, fan_in: jax.random.normal(k, shape, jnp.float32) * fan_in ** -0.5
    return {
        "x": jax.random.normal(ks[0], (BATCH, SEQ, D_MODEL), jnp.float32),
        "g_mix": 1.0 + 0.02 * jax.random.normal(ks[1], (DEPTH, D_MODEL), jnp.float32),
        "w_in": nrm(ks[2], (DEPTH, D_MODEL, PROJ_IN), D_MODEL),
        "b_f": 2.0 + 0.1 * jax.random.normal(ks[3], (DEPTH, N_HEADS_FOX), jnp.float32),
        "b_gate": 0.02 * jax.random.normal(ks[4], (DEPTH, 2 * D_MODEL), jnp.float32),
        "g_q": 1.0 + 0.02 * jax.random.normal(ks[5], (DEPTH, HEAD_DIM), jnp.float32),
        "g_k": 1.0 + 0.02 * jax.random.normal(ks[6], (DEPTH, HEAD_DIM), jnp.float32),
        "w_o_sb": nrm(ks[7], (DEPTH, W_SB, D_MODEL), W_SB),
        "w_o_fox": nrm(ks[8], (DEPTH, W_FOX, D_MODEL), W_FOX),
        "w_out": nrm(ks[9], (DEPTH, D_MODEL, D_MODEL), D_MODEL),
        "g_ffn": 1.0 + 0.02 * jax.random.normal(ks[10], (DEPTH, D_MODEL), jnp.float32),
        "w_gu_dense": nrm(ks[11], (N_DENSE, D_MODEL, 2 * D_FF), D_MODEL),
        "w_dn_dense": nrm(ks[12], (N_DENSE, D_FF, D_MODEL), D_FF),
        "w_router": nrm(ks[13], (N_MOE, D_MODEL, N_EXPERTS), D_MODEL),
        "w_gu_exp": nrm(ks[14], (N_MOE, N_EXPERTS, D_MODEL, 2 * D_FF_EXPERT), D_MODEL),
        "w_dn_exp": nrm(ks[15], (N_MOE, N_EXPERTS, D_FF_EXPERT, D_MODEL), D_FF_EXPERT),
    }


def reference(x, g_mix, w_in, b_f, b_gate, g_q, g_k, w_o_sb, w_o_fox, w_out,
              g_ffn, w_gu_dense, w_dn_dense, w_router, w_gu_exp, w_dn_exp):
    splits = [int(c) for c in np.cumsum([W_SB, W_SB, W_SB, W_FOX, W_FOX, W_FOX, N_HEADS_FOX])]
    for l in range(DEPTH):
        h = rmsnorm(x, g_mix[l])
        p = h @ w_in[l]
        q_sb, k_sb, v_sb, q_fx, k_fx, v_fx, f_pre, gate_pre = jnp.split(p, splits, axis=-1)

        y_sb = stick_breaking_attention(split_heads(q_sb, N_HEADS_SB),
                                        split_heads(k_sb, N_HEADS_SB),
                                        split_heads(v_sb, N_HEADS_SB))
        y_sb = merge_heads(y_sb) @ w_o_sb[l]

        qf = rmsnorm(split_heads(q_fx, N_HEADS_FOX), g_q[l])
        kf = rmsnorm(split_heads(k_fx, N_HEADS_FOX), g_k[l])
        log_f = jax.nn.log_sigmoid(f_pre.astype(jnp.float32) + b_f[l].astype(jnp.float32))
        y_fx = forgetting_attention(qf, kf, split_heads(v_fx, N_HEADS_FOX), log_f.transpose(0, 2, 1))
        y_fx = merge_heads(y_fx) @ w_o_fox[l]

        g_sb, g_fx = jnp.split(jax.nn.sigmoid(gate_pre + b_gate[l]), 2, axis=-1)
        x = x + (g_sb * y_sb + g_fx * y_fx) @ w_out[l]

        h = rmsnorm(x, g_ffn[l])
        if l % 2 == 0:
            x = x + swiglu(h, w_gu_dense[l // 2], w_dn_dense[l // 2])
        else:
            x = x + moe_swiglu(h, w_router[l // 2], w_gu_exp[l // 2], w_dn_exp[l // 2])
    return x
```

```cpp
#include <hip/hip_runtime.h>
#include <cstdio>
#include <cstdint>
#include <type_traits>

constexpr int DM = 1024, BATCH = 8, SEQ = 4096, M = BATCH * SEQ, NH = 8, HD = 64;
constexpr int DFF = 2816, NE = 8, DFE = 1408, PIN = 5128, NQKV = 3072, NGATE = 2048, NIN = NQKV + NGATE;
constexpr float EPS = 1e-6f;
constexpr float LOG2E = 1.4426950408889634f, LN2 = 0.6931471805599453f;
constexpr float C2 = 0.125f * LOG2E;
constexpr int QP = NQKV;
constexpr int MPAD = 2 * M + NE * 256;
constexpr float ACT_SCALE = 16.0f, WDN_SCALE = 1024.0f, DN_INV = 1.0f / (16.0f * 1024.0f);
constexpr float X8_SCALE = 8.0f, WG_SCALE = 1024.0f, GATE_INV = 1.0f / (8.0f * 1024.0f);
constexpr int DFE8 = 1536;

constexpr size_t MiB = 1u << 20;
constexpr size_t WS_CTL = 0, CTL_BYTES = 1 * MiB;
constexpr size_t WS_WIN = 1 * MiB;
constexpr size_t WS_WG8 = 13 * MiB;
constexpr size_t WS_WOSB = 21 * MiB;
constexpr size_t WS_WOFX = 23 * MiB;
constexpr size_t WS_WOUT = 25 * MiB;
constexpr size_t WS_WGU = 29 * MiB;
constexpr size_t WS_WDN = 40 * MiB;
constexpr size_t WS_WGUE = 46 * MiB;
constexpr size_t WS_WDNE = 90 * MiB;
constexpr size_t WS_XB = 112 * MiB;
constexpr size_t WS_QKV = 176 * MiB;
constexpr size_t WS_GATE = 368 * MiB;
constexpr size_t WS_SSQ = 496 * MiB;
constexpr size_t WS_LOGF = 498 * MiB;
constexpr size_t WS_CUMF = 499 * MiB;
constexpr size_t WS_RSTD = 500 * MiB;
constexpr size_t WS_TOKE = 500 * MiB + 256 * 1024;
constexpr size_t WS_TOKW = 500 * MiB + 512 * 1024;
constexpr size_t WS_LIST = 501 * MiB;
constexpr size_t WS_RPOS = 502 * MiB;
constexpr size_t WS_WPOS = 503 * MiB;
constexpr size_t WS_END = 504 * MiB;
constexpr int CW_MOECNT = 64;

typedef unsigned short bf16_t;
typedef unsigned v4u __attribute__((ext_vector_type(4)));
typedef unsigned v2u __attribute__((ext_vector_type(2)));
typedef float f32x4 __attribute__((ext_vector_type(4)));
typedef float f32x2 __attribute__((ext_vector_type(2)));
__device__ __forceinline__ unsigned cvt_pk_bf16(float lo, float hi) { typedef __bf16 bf2 __attribute__((ext_vector_type(2))); f32x2 v = {lo, hi}; bf2 b = __builtin_convertvector(v, bf2); return __builtin_bit_cast(unsigned, b); }

__device__ __forceinline__ unsigned f2bf(float f) { unsigned u = __builtin_bit_cast(unsigned, f); return (u + 0x7fffu + ((u >> 16) & 1u)) >> 16; }
__device__ __forceinline__ unsigned pk2(float lo, float hi) { return f2bf(lo) | (f2bf(hi) << 16); }
__device__ __forceinline__ float bf2f(bf16_t b) { return __builtin_bit_cast(float, (unsigned)b << 16); }
#define DPP_ADD_(v, ctrl) ((v) + __builtin_bit_cast(float, __builtin_amdgcn_update_dpp(0, __builtin_bit_cast(int, (v)), (ctrl), 0xF, 0xF, true)))
__device__ __forceinline__ float sum_x16(float v) { auto rr = __builtin_amdgcn_permlane16_swap(__float_as_uint(v), __float_as_uint(v), false, false); return __uint_as_float(rr[0]) + __uint_as_float(rr[1]); }
__device__ __forceinline__ float sum_x32(float v) { auto rr = __builtin_amdgcn_permlane32_swap(__float_as_uint(v), __float_as_uint(v), false, false); return __uint_as_float(rr[0]) + __uint_as_float(rr[1]); }
__device__ __forceinline__ float sum_quad(float v) { v = DPP_ADD_(v, 0xB1); v = DPP_ADD_(v, 0x4E); return v; }
__device__ __forceinline__ float wave_sum(float v) {
    v = sum_quad(v); v = DPP_ADD_(v, 0x141); v = DPP_ADD_(v, 0x140);
    return sum_x32(sum_x16(v));
}
__device__ __forceinline__ float sigmoidf_(float x) { return 1.f / (1.f + __expf(-x)); }

struct Ptrs {
    const float *x, *g_mix, *w_in, *b_f, *b_gate, *g_q, *g_k, *w_o_sb, *w_o_fox, *w_out, *g_ffn, *w_gu, *w_dn, *w_router, *w_gue, *w_dne;
    float* out; unsigned char* ws;
};

__host__ __device__ __forceinline__ int colperm(int s) { return ((s & 127) >> 5) * 64 + (s >> 7) * 32 + (s & 31); }
struct ConvJob { const float* src; bf16_t* dst; const float* gain; int K, ld, NB, map, hid, dpitch, dk0, f8, Kd; };
__device__ __forceinline__ int conv_src_col(const ConvJob& j, int db) {
    if (j.map == 0) return 32 * db;
    const int t = db >> 3, sb = db & 7;
    if (j.map == 1) return t * 256 + colperm(32 * sb);
    if (j.map == 4) return NQKV + 8 + (sb < 4 ? 128 * t + 32 * sb : DM + 128 * t + 32 * (sb - 4));
    if (j.map == 3) return t * 256 + colperm(32 * sb);
    return sb < 4 ? 128 * t + 32 * sb : j.hid + 128 * t + 32 * (sb - 4);
}
__device__ __forceinline__ ConvJob conv_job(const Ptrs& P, int j) {
    ConvJob c; unsigned char* ws = P.ws; c.dk0 = 0; c.dpitch = 0; c.f8 = 0; c.Kd = 0;
    if (j < 2) { c.src = P.w_in + (size_t)j * DM * PIN; c.dst = (bf16_t*)(ws + WS_WIN) + (size_t)j * NQKV * DM; c.gain = P.g_mix + j * DM; c.K = DM; c.ld = PIN; c.NB = NQKV / 32; c.map = 1; c.hid = 0; return c; }
    if (j >= 26) { const int l = j - 26; c.src = P.w_in + (size_t)l * DM * PIN; c.dst = (bf16_t*)((unsigned char*)(ws + WS_WG8) + (size_t)l * NGATE * DM); c.gain = P.g_mix + l * DM; c.K = DM; c.ld = PIN; c.NB = NGATE / 32; c.map = 4; c.hid = 0; c.f8 = 1; c.Kd = DM; return c; }
    if (j < 4) { const int l = j - 2; c.src = P.w_o_sb + (size_t)l * 512 * DM; c.dst = (bf16_t*)(ws + WS_WOSB) + (size_t)l * DM * DM; c.gain = nullptr; c.K = 512; c.ld = DM; c.NB = DM / 32; c.map = 0; c.hid = 0; c.dpitch = DM; c.dk0 = 0; return c; }
    if (j < 6) { const int l = j - 4; c.src = P.w_o_fox + (size_t)l * 512 * DM; c.dst = (bf16_t*)(ws + WS_WOSB) + (size_t)l * DM * DM; c.gain = nullptr; c.K = 512; c.ld = DM; c.NB = DM / 32; c.map = 0; c.hid = 0; c.dpitch = DM; c.dk0 = 512; return c; }
    if (j < 8) { const int l = j - 6; c.src = P.w_out + (size_t)l * DM * DM; c.dst = (bf16_t*)(ws + WS_WOUT) + (size_t)l * DM * DM; c.gain = nullptr; c.K = DM; c.ld = DM; c.NB = DM / 32; c.map = 3; c.hid = 0; return c; }
    if (j == 8) { c.src = P.w_gu; c.dst = (bf16_t*)(ws + WS_WGU); c.gain = P.g_ffn; c.K = DM; c.ld = 2 * DFF; c.NB = 2 * DFF / 32; c.map = 2; c.hid = DFF; return c; }
    if (j == 9) { c.src = P.w_dn; c.dst = (bf16_t*)(ws + WS_WDN); c.gain = nullptr; c.K = DFF; c.ld = DM; c.NB = DM / 32; c.map = 3; c.hid = 0; c.f8 = 1; c.Kd = DFF; return c; }
    if (j < 18) { const int e = j - 10; c.src = P.w_gue + (size_t)e * DM * 2 * DFE; c.dst = (bf16_t*)(ws + WS_WGUE) + (size_t)e * 2 * DFE * DM; c.gain = P.g_ffn + DM; c.K = DM; c.ld = 2 * DFE; c.NB = 2 * DFE / 32; c.map = 2; c.hid = DFE; return c; }
    { const int e = j - 18; c.src = P.w_dne + (size_t)e * DFE * DM; c.dst = (bf16_t*)((unsigned char*)(ws + WS_WDNE) + (size_t)e * DM * DFE8); c.gain = nullptr; c.K = DFE; c.ld = DM; c.NB = DM / 32; c.map = 0; c.hid = 0; c.f8 = 1; c.Kd = DFE8; return c; }
}
constexpr int NJOBS = 28;
__host__ __device__ constexpr int conv_job_items(int j) {
    return j >= 26 ? (DM / 64) * (NGATE / 32) : j < 2 ? (DM / 64) * (NQKV / 32) : j < 6 ? (512 / 64) * (DM / 32) : j < 8 ? (DM / 64) * (DM / 32) : j == 8 ? (DM / 64) * (2 * DFF / 32) : j == 9 ? (DFF / 64) * (DM / 32)
         : j < 18 ? (DM / 64) * (2 * DFE / 32) : (DFE8 / 64) * (DM / 32);
}
__host__ __device__ constexpr int conv_items_before(int j) { int s = 0; for (int i = 0; i < j; ++i) s += conv_job_items(i); return s; }
constexpr int CONV_ITEMS = conv_items_before(NJOBS);
__device__ __forceinline__ void conv_load(const ConvJob& j, int item, int lane, f32x4 (&v)[8]) {
    const int kb = item / j.NB, db = item % j.NB, k0 = 64 * kb, sc = conv_src_col(j, db);
    const int r0 = lane >> 3, c4 = (lane & 7) * 4;
    if (j.f8) {
        if (k0 < j.K) {
#pragma unroll
            for (int i = 0; i < 2; ++i) { const int q = r0 + 8 * i;
#pragma unroll
                for (int t = 0; t < 4; ++t) v[4 * i + t] = *(const f32x4*)(j.src + (size_t)(k0 + 4 * q + t) * j.ld + sc + c4); } }
        else {
#pragma unroll
            for (int i = 0; i < 8; ++i) v[i] = (f32x4){0.f, 0.f, 0.f, 0.f}; }
        return; }
#pragma unroll
    for (int i = 0; i < 4; ++i) { const int q = r0 + 8 * i; v[2 * i] = *(const f32x4*)(j.src + (size_t)(k0 + 2 * q) * j.ld + sc + c4); v[2 * i + 1] = *(const f32x4*)(j.src + (size_t)(k0 + 2 * q + 1) * j.ld + sc + c4); }
}
template <class LP> __device__ __forceinline__ void conv_finish(const ConvJob& j, int item, LP scr, int lane, const f32x4 (&v)[8]) {
    const int kb = item / j.NB, db = item % j.NB, k0 = 64 * kb;
    const int r0 = lane >> 3, c4 = (lane & 7) * 4;
    auto scr32 = (decltype(scr))scr;
    if (j.f8) {
#pragma unroll
        for (int i = 0; i < 2; ++i) { const int q = r0 + 8 * i;
            const float g0 = (j.gain ? j.gain[k0 + 4 * q] : 1.0f) * WDN_SCALE, g1 = (j.gain ? j.gain[k0 + 4 * q + 1] : 1.0f) * WDN_SCALE, g2 = (j.gain ? j.gain[k0 + 4 * q + 2] : 1.0f) * WDN_SCALE, g3 = (j.gain ? j.gain[k0 + 4 * q + 3] : 1.0f) * WDN_SCALE;
#pragma unroll
            for (int c = 0; c < 4; ++c) { int w = 0; w = __builtin_amdgcn_cvt_pk_fp8_f32(v[4 * i][c] * g0, v[4 * i + 1][c] * g1, w, false); w = __builtin_amdgcn_cvt_pk_fp8_f32(v[4 * i + 2][c] * g2, v[4 * i + 3][c] * g3, w, true);
                scr32[(c4 + c) * 18 + q] = __builtin_bit_cast(float, w); } }
        asm volatile("s_waitcnt lgkmcnt(0)" ::: "memory");
        const int ch = lane & 3;
#pragma unroll
        for (int jj = 0; jj < 2; ++jj) { const int n = (lane >> 2) + 16 * jj; auto s = scr32 + n * 18 + 4 * ch;
            v4u o; o.x = __builtin_bit_cast(unsigned, s[0]); o.y = __builtin_bit_cast(unsigned, s[1]); o.z = __builtin_bit_cast(unsigned, s[2]); o.w = __builtin_bit_cast(unsigned, s[3]);
            *(v4u*)((unsigned char*)j.dst + (size_t)(32 * db + n) * j.Kd + k0 + 16 * ch) = o; }
        asm volatile("s_waitcnt lgkmcnt(0)" ::: "memory");
        return; }
#pragma unroll
    for (int i = 0; i < 4; ++i) { const int q = r0 + 8 * i; const float g0 = j.gain ? j.gain[k0 + 2 * q] : 1.0f, g1 = j.gain ? j.gain[k0 + 2 * q + 1] : 1.0f;
#pragma unroll
        for (int c = 0; c < 4; ++c) scr32[(c4 + c) * 34 + q] = __builtin_bit_cast(float, cvt_pk_bf16(v[2 * i][c] * g0, v[2 * i + 1][c] * g1)); }
    asm volatile("s_waitcnt lgkmcnt(0)" ::: "memory");
    const int c = lane & 7;
#pragma unroll
    for (int jj = 0; jj < 4; ++jj) { const int n = (lane >> 3) + 8 * jj; auto s = scr32 + n * 34 + 4 * c;
        v4u o; o.x = __builtin_bit_cast(unsigned, s[0]); o.y = __builtin_bit_cast(unsigned, s[1]); o.z = __builtin_bit_cast(unsigned, s[2]); o.w = __builtin_bit_cast(unsigned, s[3]);
        *(v4u*)(j.dst + (size_t)(32 * db + n) * (j.dpitch ? j.dpitch : j.K) + j.dk0 + k0 + 8 * c) = o; }
    asm volatile("s_waitcnt lgkmcnt(0)" ::: "memory");
}
template <class LP> __device__ __forceinline__ void conv_item(const ConvJob& j, int item, LP scr, int lane) { f32x4 v[8]; conv_load(j, item, lane, v); conv_finish(j, item, scr, lane, v); }
__device__ __forceinline__ int conv_find(int it, int& r) { int j = 0; r = it;
#pragma unroll 1
    for (; j < NJOBS; ++j) { const int n = conv_job_items(j); if (r < n) break; r -= n; }
    return j; }
__device__ __forceinline__ void conv_dispatch(const Ptrs& P, int it, float* scr, int lane) {
    int j = 0, r = it;
#pragma unroll 1
    for (; j < NJOBS; ++j) { const int n = conv_job_items(j); if (r < n) break; r -= n; }
    const ConvJob c = conv_job(P, j); conv_item(c, r, scr, lane);
}

#ifndef LAS
#define LAS __attribute__((address_space(3)))
#endif
template <int MODE> __device__ __forceinline__ void row_pass_fill(const Ptrs& P, LAS float* wt, int tid) {
    const int l = MODE == 0 ? 0 : 1;
    const float* W = MODE == 2 ? P.w_router : P.w_in + (size_t)l * DM * PIN + NQKV; const int ld = MODE == 2 ? NE : PIN;
    const float* g = MODE == 2 ? P.g_ffn + DM : P.g_mix + l * DM;
    for (int i = tid; i < 8 * DM; i += 512) { const int k = i >> 3, e = i & 7; wt[e * DM + k] = W[(size_t)k * ld + e] * g[k]; }
}
template <int MODE, bool WLDS = false> __device__ __forceinline__ void row_pass(const Ptrs& P, int gw, int ngw, int lane, LAS const float* wt = nullptr, int mend = M) {
    unsigned char* ws = P.ws;
    const float* res = P.x; const bf16_t* resb = (const bf16_t*)(P.ws + WS_XB);
    const int l = MODE == 0 ? 0 : 1;
    float w[8][16];
    if (!WLDS) {
        const float* W = MODE == 2 ? P.w_router : P.w_in + (size_t)l * DM * PIN + NQKV; const int ld = MODE == 2 ? NE : PIN;
        const float* g = MODE == 2 ? P.g_ffn + DM : P.g_mix + l * DM;
#pragma unroll
        for (int j = 0; j < 4; ++j)
#pragma unroll
            for (int c = 0; c < 4; ++c) { const int k = 4 * lane + 256 * j + c; const float gk = g[k];
#pragma unroll
                for (int e = 0; e < 8; ++e) w[e][4 * j + c] = W[(size_t)k * ld + e] * gk; }
    }
    float bfv[8];
#pragma unroll
    for (int e = 0; e < 8; ++e) bfv[e] = MODE == 2 ? 0.f : P.b_f[l * NH + e];
    float* logf = (float*)(ws + WS_LOGF);
    int ent_e = -1, ent_v = 0, nent = 0; float ent_r = 0.f, ent_w = 0.f;
    unsigned* cnt = (unsigned*)(ws + WS_CTL) + CW_MOECNT; int* list = (int*)(ws + WS_LIST);
#define ROUTER_FLUSH() do {     \
        unsigned long long mk_ = 0ull; int cn_ = 0; \
        _Pragma("unroll") for (int e_ = 0; e_ < NE; ++e_) { const unsigned long long m_ = __ballot(ent_e == e_); if (ent_e == e_) mk_ = m_; if (lane == e_) cn_ = __popcll(m_); } \
        unsigned base_ = 0; if (lane < NE && cn_ > 0) base_ = atomicAdd(cnt + lane, (unsigned)cn_); \
        const unsigned mybase_ = (unsigned)__shfl((int)base_, ent_e < 0 ? 0 : ent_e); \
        if (ent_e >= 0) { const int rank = __popcll(mk_ & ((1ull << lane) - 1ull)); const size_t o_ = (size_t)ent_e * M + mybase_ + rank; \
            list[o_] = ent_v; ((float*)(ws + WS_RPOS))[o_] = ent_r; ((float*)(ws + WS_WPOS))[o_] = ent_w; } \
        ent_e = -1; nent = 0; } while (0)
    typedef typename std::conditional<MODE == 0, f32x4, unsigned long long>::type raw_t;
    raw_t r1[4], r2[4];
#define ROW_LOAD(dst_, m_) do { if constexpr (MODE == 0) { _Pragma("unroll") for (int j = 0; j < 4; ++j) dst_[j] = ((const f32x4*)(res + (size_t)(m_) * DM) + lane)[64 * j]; } \
        else { _Pragma("unroll") for (int j = 0; j < 4; ++j) dst_[j] = ((const unsigned long long*)(resb + (size_t)(m_) * DM) + lane)[64 * j]; } } while (0)
    if (gw < mend) ROW_LOAD(r1, gw);
    if (gw + ngw < mend) ROW_LOAD(r2, gw + ngw);
    auto row_body = [&](const int m, raw_t (&R)[4]) __attribute__((always_inline)) {
        f32x4 v[4]; float s = 0.f;
#pragma unroll
        for (int j = 0; j < 4; ++j) {
            if constexpr (MODE == 0) v[j] = R[j];
            else { const unsigned long long t_ = R[j]; v[j] = (f32x4){__builtin_bit_cast(float, (unsigned)t_ << 16), __builtin_bit_cast(float, (unsigned)t_ & 0xffff0000u), __builtin_bit_cast(float, (unsigned)(t_ >> 32) << 16), __builtin_bit_cast(float, (unsigned)(t_ >> 32) & 0xffff0000u)}; }
            s = fmaf(v[j].x, v[j].x, s); s = fmaf(v[j].y, v[j].y, s); s = fmaf(v[j].z, v[j].z, s); s = fmaf(v[j].w, v[j].w, s); }
        if (m + 2 * ngw < mend) ROW_LOAD(R, m + 2 * ngw);
        s = wave_sum(s);
        float d[8];
#pragma unroll
        for (int e = 0; e < 8; ++e) { float a = 0.f;
#pragma unroll
            for (int j = 0; j < 4; ++j) { f32x4 ww; if (WLDS) ww = *(const LAS f32x4*)(wt + e * DM + 4 * lane + 256 * j); else ww = (f32x4){w[e][4 * j], w[e][4 * j + 1], w[e][4 * j + 2], w[e][4 * j + 3]};
                a = fmaf(v[j].x, ww.x, a); a = fmaf(v[j].y, ww.y, a); a = fmaf(v[j].z, ww.z, a); a = fmaf(v[j].w, ww.w, a); }
            d[e] = wave_sum(a); }
        const float rstd = __builtin_amdgcn_rsqf(s * (1.0f / DM) + EPS);
        if (MODE == 0) {
            unsigned long long* o8 = (unsigned long long*)((bf16_t*)(ws + WS_XB) + (size_t)m * DM) + lane;
#pragma unroll
            for (int j = 0; j < 4; ++j) o8[64 * j] = (unsigned long long)cvt_pk_bf16(v[j].x, v[j].y) | ((unsigned long long)cvt_pk_bf16(v[j].z, v[j].w) << 32);
            unsigned* o4 = (unsigned*)((unsigned char*)P.out + (size_t)m * DM) + lane;
#pragma unroll
            for (int j = 0; j < 4; ++j) { int w_ = 0; w_ = __builtin_amdgcn_cvt_pk_fp8_f32(v[j].x * X8_SCALE, v[j].y * X8_SCALE, w_, false); w_ = __builtin_amdgcn_cvt_pk_fp8_f32(v[j].z * X8_SCALE, v[j].w * X8_SCALE, w_, true); o4[64 * j] = (unsigned)w_; }
            if (lane < 16) ((float*)(ws + WS_SSQ))[(size_t)m * 16 + lane] = lane == 0 ? s : 0.f;
        }
        if (MODE != 2) {
            float z = 0.f;
#pragma unroll
            for (int e = 0; e < 8; ++e) { const float ze = d[e] * rstd + bfv[e]; if (lane == e) z = ze; }
            const float val = fminf(z, 0.f) - log1pf(__expf(-fabsf(z)));
            const int b = m / SEQ, sp = m % SEQ;
            if (lane < 8) logf[(size_t)(b * NH + lane) * SEQ + sp] = val;
        } else {
            int e0 = 0; float v0 = d[0] * rstd;
#pragma unroll
            for (int e = 1; e < 8; ++e) { const float t = d[e] * rstd; if (t > v0) { v0 = t; e0 = e; } }
            int e1 = -1; float v1 = -INFINITY;
#pragma unroll
            for (int e = 0; e < 8; ++e) { const float t = d[e] * rstd; if (e != e0 && t > v1) { v1 = t; e1 = e; } }
            const float w1 = 1.f / (1.f + __expf(v0 - v1)), w0 = 1.f - w1;
            if (lane == 0) { ((float*)(ws + WS_RSTD))[m] = rstd; ((int*)(ws + WS_TOKE))[2 * m] = e0; ((int*)(ws + WS_TOKE))[2 * m + 1] = e1;
                ((float*)(ws + WS_TOKW))[2 * m] = w0; ((float*)(ws + WS_TOKW))[2 * m + 1] = w1; }
            if (lane == nent) { ent_e = e0; ent_v = 2 * m; ent_r = rstd; ent_w = w0; } if (lane == nent + 1) { ent_e = e1; ent_v = 2 * m + 1; ent_r = rstd; ent_w = w1; }
            nent += 2; if (nent == 64) ROUTER_FLUSH();
        }
    };
    for (int m = gw; m < mend; m += 2 * ngw) { row_body(m, r1); if (m + ngw < mend) row_body(m + ngw, r2); }
    if (MODE == 2) {
        LAS unsigned* wc = (LAS unsigned*)(wt + 8 * DM);
        const int wv = gw & 7;
        unsigned long long mk_ = 0ull; int cn_ = 0;
#pragma unroll
        for (int e_ = 0; e_ < NE; ++e_) { const unsigned long long m_ = __ballot(ent_e == e_); if (ent_e == e_) mk_ = m_; if (lane == e_) cn_ = __popcll(m_); }
        if (lane < NE) wc[wv * 8 + lane] = (unsigned)cn_;
        asm volatile("s_waitcnt lgkmcnt(0)\n\ts_barrier" ::: "memory");
        if (wv == 0 && lane < NE) { unsigned tot = 0;
#pragma unroll
            for (int w_ = 0; w_ < 8; ++w_) tot += wc[w_ * 8 + lane];
            unsigned base_ = 0; if (tot > 0) base_ = atomicAdd(cnt + lane, tot); wc[64 + lane] = base_; }
        asm volatile("s_waitcnt vmcnt(0) lgkmcnt(0)\n\ts_barrier" ::: "memory");
        unsigned base_ = 0;
        if (lane < NE) { base_ = wc[64 + lane];
#pragma unroll
            for (int w_ = 0; w_ < 8; ++w_) base_ += (w_ < wv) ? wc[w_ * 8 + lane] : 0u; }
        const unsigned mybase_ = (unsigned)__shfl((int)base_, ent_e < 0 ? 0 : ent_e);
        if (ent_e >= 0) { const int rank = __popcll(mk_ & ((1ull << lane) - 1ull)); const size_t o_ = (size_t)ent_e * M + mybase_ + rank;
            list[o_] = ent_v; ((float*)(ws + WS_RPOS))[o_] = ent_r; ((float*)(ws + WS_WPOS))[o_] = ent_w; }
    }
#undef ROUTER_FLUSH
#undef ROW_LOAD
}

struct MoeLoc { int e, pos, cnt, total; };
__device__ __forceinline__ MoeLoc moe_locate(const unsigned char* ws, int v) {
    const unsigned* cnt = (const unsigned*)(ws + WS_CTL) + CW_MOECNT; int b = 0; MoeLoc L; L.e = 0; L.pos = 0; L.cnt = 0;
#pragma unroll
    for (int e = 0; e < NE; ++e) { const int c = (int)__hip_atomic_load(cnt + e, __ATOMIC_RELAXED, __HIP_MEMORY_SCOPE_AGENT); if (v >= b) { L.e = e; L.pos = v - b; L.cnt = c; } b += (c + 255) & ~255; }
    L.total = b; return L;
}

#ifndef LAS
#define LAS __attribute__((address_space(3)))
#endif
typedef short bf16x8 __attribute__((ext_vector_type(8)));
typedef float f32x16 __attribute__((ext_vector_type(16)));
typedef short s16x4 __attribute__((ext_vector_type(4)));

__device__ __forceinline__ float fast_sigmoid(float x) { return __builtin_amdgcn_rcpf(1.0f + __builtin_amdgcn_exp2f(-LOG2E * x)); }
__device__ __forceinline__ float bflo(unsigned u) { return __builtin_bit_cast(float, u << 16); }
__device__ __forceinline__ float bfhi(unsigned u) { return __builtin_bit_cast(float, u & 0xffff0000u); }

#ifndef PG8_ALIGN_EPI
#define PG8_ALIGN_EPI 1
#endif
namespace pg8 {
constexpr int BM = 256, BK = 64, HALF = 128, HTB = HALF * BK * 2, STAGE_BYTES = 8 * HTB, NXCD = 8, WGM = 8;
__device__ __forceinline__ int lds_byte(int r, int c) { return (r >> 3) * 1024 + (r & 7) * 128 + ((((c >> 3) ^ (r >> 1)) & 7) << 4) + (c & 7) * 2; }
__device__ __forceinline__ void stage_rc(int b, int& R, int& C) { const int st = b / 1024, sb = b % 1024; R = st * 8 + sb / 128; C = ((((sb % 128) >> 4) ^ (R >> 1)) & 7) * 8; }
__device__ __forceinline__ int perm32(int rho) { const int n = rho >> 4, i = rho & 15; return 8 * (i >> 2) + 4 * n + (i & 3); }

struct Unit { const char* b; int pm, pn, e, pos0, cnt, pad; };

struct StaticOrder {
    const char* Bt; int nM, nN, nwg, G, c, K;
    __device__ void init(const bf16_t* Bt_, int nM_, int nN_, int K_, int G_, int c_) { Bt = (const char*)Bt_; nM = nM_; nN = nN_; nwg = nM * nN; G = G_; c = c_; K = K_; }
    __device__ bool next(int i, Unit& u) const {
        const long L = (long)i * G + c; if (L >= nwg) return false;
        int wgid = (int)L; { const int q = nwg / NXCD, r = nwg % NXCD, xcd = wgid % NXCD, off = wgid / NXCD; wgid = (xcd < r ? xcd * (q + 1) : r * (q + 1) + (xcd - r) * q) + off; }
        const int nig = WGM * nN, gid = wgid / nig, fm = gid * WGM, gsz = (nM - fm) < WGM ? (nM - fm) : WGM;
        u.pm = fm + ((wgid % nig) % gsz); u.pn = (wgid % nig) / gsz; u.b = Bt + (size_t)u.pn * BM * K * 2; u.e = 0; u.pos0 = 0; u.cnt = 0; u.pad = i; return true;
    }
    __device__ __forceinline__ int a_row(const Unit& u, int r) const { return u.pm * BM + r; }
};
struct MoeOrder {
    const char* W; const int* list; size_t wstride; int nN, K, G, c, gather; int cnt[NE];
    __device__ void init(const unsigned char* ws, const bf16_t* W_, size_t wstride_bytes, int nN_, int K_, int G_, int c_, int gather_) {
        W = (const char*)W_; wstride = wstride_bytes; nN = nN_; K = K_; G = G_; c = c_; gather = gather_; list = (const int*)(ws + WS_LIST);
        const unsigned* cw = (const unsigned*)(ws + WS_CTL) + CW_MOECNT;
#pragma unroll
        for (int e = 0; e < NE; ++e) cnt[e] = __builtin_amdgcn_readfirstlane((int)__hip_atomic_load(cw + e, __ATOMIC_RELAXED, __HIP_MEMORY_SCOPE_AGENT));
    }
    __device__ bool next(int i, Unit& u) const {
        int PT = 0;
#pragma unroll
        for (int e = 0; e < NE; ++e) PT += (cnt[e] + 255) >> 8;
        const int nwg = PT * nN; const long L = (long)i * G + c; if (L >= nwg) return false;
        int wgid = (int)L; { const int q = nwg / NXCD, r = nwg % NXCD, xcd = wgid % NXCD, off = wgid / NXCD; wgid = (xcd < r ? xcd * (q + 1) : r * (q + 1) + (xcd - r) * q) + off; }
        const int nig = WGM * nN, gid = wgid / nig, fm = gid * WGM, gsz = (PT - fm) < WGM ? (PT - fm) : WGM;
        const int pp = fm + ((wgid % nig) % gsz), pn = (wgid % nig) / gsz;
        int pb = 0, found = 0; u.e = 0; u.pos0 = 0; u.cnt = 0; u.pm = 0;
#pragma unroll
        for (int e = 0; e < NE; ++e) { const int np = (cnt[e] + 255) >> 8; if (!found && pp < pb + np) { found = 1; u.e = e; u.pos0 = (pp - pb) * 256; u.cnt = cnt[e]; u.pm = pp; } pb += np; }
        if (!found) return false;
        u.pn = pn; u.pad = i; u.b = W + (size_t)u.e * wstride + (size_t)pn * BM * K * 2; return true;
    }
    __device__ __forceinline__ int a_row(const Unit& u, int r) const {
        if (!gather) return u.pm * BM + r;
        const int pos = u.pos0 + r; return pos < u.cnt ? list[(size_t)u.e * M + pos] >> 1 : 0;
    }
};

template <bool SKIP_EPI = false, bool MID = false, bool F8 = false, class Epi, class Sched>
__device__ __forceinline__ void gemm_phase(LAS unsigned char* lds, const char* A, const int lda, const int K, const Sched& S, const Epi& E, const int tid, const int ksplit = 2, const size_t ajump = 0) {
    const int wid = __builtin_amdgcn_readfirstlane(tid >> 6), lane = tid & 63, wr = wid >> 2, wc = wid & 3, fr = lane & 15, fq = lane >> 4;
    const int nt = K / BK;
    int Rl[2], Cl[2]; unsigned voffB[2];
#pragma unroll
    for (int i = 0; i < 2; ++i) { int R, C; stage_rc(tid * 16 + i * 8192, R, C); Rl[i] = R; Cl[i] = C; const int Rb = (R & ~31) + perm32(R & 31); voffB[i] = (unsigned)(Rb * K + C) * 2u; }
    const size_t kstep = (size_t)(BK * 2);
    const size_t hstepB = (size_t)HALF * K * 2;
    const unsigned ldsw = (unsigned)wid * 1024u;
    const int aoff = lds_byte(wr * 64 + fr, fq * 8), boff = lds_byte(wc * 32 + fr, fq * 8), aoff1 = lds_byte(wr * 64 + fr, fq * 8 + 32) - aoff, boff1 = lds_byte(wc * 32 + fr, fq * 8 + 32) - boff;
#define PG8_SA(b, h) (((b) * 2 + (h)) * HTB)
#define PG8_SB(b, h) ((4 + (b) * 2 + (h)) * HTB)
#define PG8_STAGE(bufoff, gbase, voff) do { _Pragma("unroll") for (int _i = 0; _i < 2; ++_i) \
        __builtin_amdgcn_global_load_lds((const unsigned*)((const char*)(gbase) + (voff)[_i]), (LAS unsigned*)(lds + (bufoff) + ldsw + _i * 8192), 16, 0, 0); } while (0)
#define PG8_LDA(dst, b, h) do { _Pragma("unroll") for (int m = 0; m < 4; ++m) { \
        if constexpr (F8) { const v4i_ lo_ = *(const LAS v4i_*)(lds + PG8_SA(b, h) + aoff + m * 2048), hi_ = *(const LAS v4i_*)(lds + PG8_SA(b, h) + aoff + m * 2048 + aoff1); \
            dst[m][0] = __builtin_shufflevector(lo_, hi_, 0, 1, 2, 3, 4, 5, 6, 7); } \
        else { _Pragma("unroll") for (int k = 0; k < 2; ++k) dst[m][k] = *(const LAS bf16x8*)(lds + PG8_SA(b, h) + aoff + m * 2048 + k * aoff1); } } } while (0)
#define PG8_LDB(dst, b, h) do { _Pragma("unroll") for (int n = 0; n < 2; ++n) { \
        if constexpr (F8) { const v4i_ lo_ = *(const LAS v4i_*)(lds + PG8_SB(b, h) + boff + n * 2048), hi_ = *(const LAS v4i_*)(lds + PG8_SB(b, h) + boff + n * 2048 + boff1); \
            dst[n][0] = __builtin_shufflevector(lo_, hi_, 0, 1, 2, 3, 4, 5, 6, 7); } \
        else { _Pragma("unroll") for (int k = 0; k < 2; ++k) dst[n][k] = *(const LAS bf16x8*)(lds + PG8_SB(b, h) + boff + n * 2048 + k * boff1); } } } while (0)
#define PG8_MMA(ai, bj, At, Bt) do { __builtin_amdgcn_s_setprio(3); \
        if constexpr (F8) { _Pragma("unroll") for (int m = 0; m < 4; ++m) _Pragma("unroll") for (int n = 0; n < 2; ++n) \
            asm volatile("v_mfma_scale_f32_16x16x128_f8f6f4 %0, %1, %2, %0, %3, %3 op_sel_hi:[0,0,0]" : "+v"(acc[ai][bj][m][n]) : "v"(Bt[n][0]), "v"(At[m][0]), "v"(sc127)); }         \
        else { _Pragma("unroll") for (int m = 0; m < 4; ++m) _Pragma("unroll") for (int n = 0; n < 2; ++n) _Pragma("unroll") for (int k = 0; k < 2; ++k) \
            acc[ai][bj][m][n] = __builtin_amdgcn_mfma_f32_16x16x32_bf16(Bt[n][k], At[m][k], acc[ai][bj][m][n], 0, 0, 0); } \
        __builtin_amdgcn_s_setprio(0); } while (0)
#define PG8_WAIT_V(n) asm volatile("s_waitcnt vmcnt(" #n ")" ::: "memory")
#define PG8_WAIT_L(n) asm volatile("s_waitcnt lgkmcnt(" #n ")" ::: "memory")
#define PG8_BAR __builtin_amdgcn_s_barrier()
#define PG8_SCHED __builtin_amdgcn_sched_barrier(0)
#define PG8_UOFF(u, off) do { _Pragma("unroll") for (int _h = 0; _h < 2; ++_h) _Pragma("unroll") for (int _i = 0; _i < 2; ++_i) \
        off[_h][_i] = (unsigned)(S.a_row(u, _h * HALF + Rl[_i]) * lda + Cl[_i]) * 2u; } while (0)
    Unit cur, nxt; int ui = 0;
    if (!S.next(0, cur)) return;
    unsigned coff[2][2], noff[2][2];
    PG8_UOFF(cur, coff);
    f32x4 acc[2][2][4][2];
#pragma unroll
    for (int a = 0; a < 2; ++a)
#pragma unroll
        for (int b = 0; b < 2; ++b)
#pragma unroll
            for (int m = 0; m < 4; ++m)
#pragma unroll
                for (int n = 0; n < 2; ++n) acc[a][b][m][n] = (f32x4){0.f, 0.f, 0.f, 0.f};
    typedef int v4i_ __attribute__((ext_vector_type(4))); typedef int v8i_ __attribute__((ext_vector_type(8)));
    int sc127 = 127; asm volatile("" : "+v"(sc127));
    typename std::conditional<F8, v8i_, bf16x8>::type At[4][F8 ? 1 : 2], B0[2][F8 ? 1 : 2], B1[2][F8 ? 1 : 2];
    const char* cB = cur.b;
    PG8_STAGE(PG8_SB(0, 0), cB, voffB); PG8_STAGE(PG8_SB(0, 1), cB + hstepB, voffB); PG8_STAGE(PG8_SA(0, 0), A, coff[0]); PG8_STAGE(PG8_SA(0, 1), A, coff[1]);
    if (wr == 1) PG8_BAR;
    PG8_WAIT_V(2); PG8_BAR;
    PG8_STAGE(PG8_SB(1, 0), cB + kstep, voffB); PG8_STAGE(PG8_SA(1, 0), A + kstep, coff[0]); PG8_STAGE(PG8_SB(1, 1), cB + hstepB + kstep, voffB);
    PG8_WAIT_V(6); PG8_BAR;
    for (;;) {
        const bool has_next = S.next(ui + 1, nxt);
        if (has_next) { PG8_UOFF(nxt, noff); } else {
#pragma unroll
            for (int h = 0; h < 2; ++h)
#pragma unroll
                for (int i = 0; i < 2; ++i) noff[h][i] = coff[h][i]; }
        const char* nB = has_next ? nxt.b : cB;
        for (int t = 0; t < nt; t += 2) {
            const bool last = (t == nt - 2);
#define PG8_AK(kt) (A + (size_t)(kt) * kstep + ((kt) >= ksplit ? ajump : (size_t)0))
            const char* a1 = PG8_AK(t + 1);
            const char* a2 = last ? A : PG8_AK(t + 2); const char* b2 = last ? nB : cB + (size_t)(t + 2) * kstep;
            const char* a3 = last ? A + kstep : PG8_AK(t + 3); const char* b3 = b2 + kstep;
            unsigned o2[2][2];
#pragma unroll
            for (int h = 0; h < 2; ++h)
#pragma unroll
                for (int i = 0; i < 2; ++i) o2[h][i] = last ? noff[h][i] : coff[h][i];
            PG8_LDB(B0, 0, 0); PG8_LDB(B1, 0, 1); PG8_SCHED; PG8_LDA(At, 0, 0); PG8_STAGE(PG8_SA(1, 1), a1, coff[1]);
            PG8_WAIT_V(8); PG8_WAIT_L(0); PG8_BAR; PG8_MMA(0, 0, At, B0); PG8_MMA(0, 1, At, B1); PG8_BAR; PG8_SCHED;
            PG8_LDA(At, 0, 1); PG8_STAGE(PG8_SB(0, 0), b2, voffB); PG8_STAGE(PG8_SB(0, 1), b2 + hstepB, voffB); PG8_STAGE(PG8_SA(0, 0), a2, o2[0]);
            PG8_WAIT_V(8); PG8_WAIT_L(0); PG8_BAR; PG8_MMA(1, 0, At, B0); PG8_MMA(1, 1, At, B1); PG8_BAR; PG8_SCHED;
            PG8_LDB(B0, 1, 0); PG8_LDB(B1, 1, 1); PG8_SCHED; PG8_LDA(At, 1, 0); PG8_STAGE(PG8_SA(0, 1), a2, o2[1]);
            PG8_WAIT_V(8); PG8_WAIT_L(0); PG8_BAR; PG8_MMA(0, 0, At, B0); PG8_MMA(0, 1, At, B1); PG8_BAR; PG8_SCHED;
            PG8_LDA(At, 1, 1); PG8_STAGE(PG8_SB(1, 0), b3, voffB); PG8_STAGE(PG8_SB(1, 1), b3 + hstepB, voffB); PG8_STAGE(PG8_SA(1, 0), a3, o2[0]);
            PG8_WAIT_V(8); PG8_WAIT_L(0); PG8_BAR; PG8_MMA(1, 0, At, B0); PG8_MMA(1, 1, At, B1); PG8_BAR; PG8_SCHED;
            if constexpr (MID) { if (t + 2 == ksplit) E.mid(acc, cur, wr, wc, fr, fq); }
        }
        if constexpr (F8) asm volatile("s_nop 15\n\ts_nop 15" ::: "memory");
        if (PG8_ALIGN_EPI) { if (wr == 0) PG8_BAR; }
        if (!SKIP_EPI) E(acc, cur, wr, wc, fr, fq); else { _Pragma("unroll") for (int a_ = 0; a_ < 2; ++a_) _Pragma("unroll") for (int b_ = 0; b_ < 2; ++b_) _Pragma("unroll") for (int m_ = 0; m_ < 4; ++m_) asm volatile("" :: "v"(acc[a_][b_][m_][0]), "v"(acc[a_][b_][m_][1])); }
        if (!has_next) break;
        cur = nxt; cB = nB; ++ui;
#pragma unroll
        for (int h = 0; h < 2; ++h)
#pragma unroll
            for (int i = 0; i < 2; ++i) coff[h][i] = noff[h][i];
        if (PG8_ALIGN_EPI) { if (wr == 1) PG8_BAR; }
    }
    PG8_WAIT_V(0);
    if (!PG8_ALIGN_EPI) { if (wr == 0) PG8_BAR; }
    PG8_BAR;
#undef PG8_SA
#undef PG8_SB
#undef PG8_STAGE
#undef PG8_LDA
#undef PG8_LDB
#undef PG8_MMA
#undef PG8_WAIT_V
#undef PG8_WAIT_L
#undef PG8_BAR
#undef PG8_SCHED
#undef PG8_UOFF
#undef PG8_AK
}

typedef f32x4 Acc[2][2][4][2];
#define PG8_ZERO_ROW(ai_, m_) do { acc[ai_][0][m_][0] = (f32x4){0.f, 0.f, 0.f, 0.f}; acc[ai_][0][m_][1] = (f32x4){0.f, 0.f, 0.f, 0.f}; acc[ai_][1][m_][0] = (f32x4){0.f, 0.f, 0.f, 0.f}; acc[ai_][1][m_][1] = (f32x4){0.f, 0.f, 0.f, 0.f}; } while (0)
constexpr int RSL_OFF = 132096, RSL_UNITS = 13;
template <class Sched> __device__ __forceinline__ void fill_rstd(LAS unsigned char* lds, const float* ssq, const Sched& S, int tid) {
    LAS float* tab = (LAS float*)(lds + RSL_OFF); const int lane = tid & 63, wid = __builtin_amdgcn_readfirstlane(tid >> 6); Unit u;
    for (int i = wid; i < RSL_UNITS && S.next(i, u); i += 8) {
        f32x4 p[16];
#pragma unroll
        for (int k = 0; k < 16; ++k) p[k] = *(const f32x4*)(ssq + (size_t)(u.pm * BM + (lane >> 2) + 16 * k) * 16 + 4 * (lane & 3));
#pragma unroll
        for (int k = 0; k < 16; ++k) { float s_ = (p[k].x + p[k].y) + (p[k].z + p[k].w); s_ = sum_quad(s_);
            if ((lane & 3) == 0) tab[i * 256 + (lane >> 2) + 16 * k] = __builtin_amdgcn_rsqf(s_ * (1.0f / DM) + EPS); }
    }
    asm volatile("s_waitcnt vmcnt(0) lgkmcnt(0)\n\ts_barrier" ::: "memory");
}
__device__ __forceinline__ void fill_rstd_moe(LAS unsigned char* lds, const float* rpos, const MoeOrder& S, int tid) {
    LAS float* tab = (LAS float*)(lds + RSL_OFF); const int lane = tid & 63, wid = __builtin_amdgcn_readfirstlane(tid >> 6); Unit u;
    for (int i = wid; i < RSL_UNITS && S.next(i, u); i += 8) {
#pragma unroll
        for (int k = 0; k < 4; ++k) { const int pos = u.pos0 + lane + 64 * k; tab[i * 256 + lane + 64 * k] = pos < u.cnt ? rpos[(size_t)u.e * M + pos] : 0.f; }
    }
    asm volatile("s_waitcnt vmcnt(0) lgkmcnt(0)\n\ts_barrier" ::: "memory");
}
__device__ __forceinline__ void rows_rstd(LAS const float* rsl, const Unit& u, int wr, int fr, float (&rs)[2][4]) {
#pragma unroll
    for (int ai = 0; ai < 2; ++ai)
#pragma unroll
        for (int m = 0; m < 4; ++m) rs[ai][m] = rsl[u.pad * 256 + wr * 64 + fr + ai * HALF + m * 16];
}
__device__ __forceinline__ v4u pack8(const f32x4 a, const f32x4 b) { v4u w; w.x = cvt_pk_bf16(a[0], a[1]); w.y = cvt_pk_bf16(a[2], a[3]); w.z = cvt_pk_bf16(b[0], b[1]); w.w = cvt_pk_bf16(b[2], b[3]); return w; }

__device__ __forceinline__ v4u lane_t4(v4u x, int lane) {
    const int src = (((lane & 3) << 4) | (lane >> 2)) << 2; v4u r;
#pragma unroll
    for (int k = 0; k < 4; ++k) r[k] = (unsigned)__builtin_amdgcn_ds_bpermute(src, (int)x[k]);
    return r;
}
struct EpiIn {
    bf16_t* qkv; LAS const float* rsl; const float* g_q; const float* g_k;
    __device__ __forceinline__ void operator()(Acc& acc, const Unit& u, int wr, int wc, int fr, int fq) const {
        const int row0 = u.pm * BM + wr * 64 + fr, j = u.pn;
        float rs[2][4]; rows_rstd(rsl, u, wr, fr, rs);
        {
            const int which = j >> 1; const bool nrm = (which == 3 || which == 4);
            f32x4 gv[2][2];
#pragma unroll
            for (int bj = 0; bj < 2; ++bj)
#pragma unroll
                for (int n = 0; n < 2; ++n) gv[bj][n] = nrm ? *(const f32x4*)((which == 3 ? g_q : g_k) + 32 * bj + 8 * fq + 4 * n) : (f32x4){1.f, 1.f, 1.f, 1.f};
            const float cs = (which == 0 || which == 3) ? C2 : 1.0f;
            const int ln_ = fq * 16 + fr;
            bf16_t* base = qkv + (size_t)(u.pm * BM + wr * 64 + (ln_ >> 2)) * QP + j * 256 + wc * 64 + 8 * (ln_ & 3);
#pragma unroll
            for (int ai = 0; ai < 2; ++ai)
#pragma unroll
                for (int m = 0; m < 4; ++m) {
                    f32x4 v[2][2]; float ss = 0.f;
#pragma unroll
                    for (int bj = 0; bj < 2; ++bj)
#pragma unroll
                        for (int n = 0; n < 2; ++n) { v[bj][n] = acc[ai][bj][m][n] * rs[ai][m]; const f32x4 q = v[bj][n] * v[bj][n]; ss += (q[0] + q[1]) + (q[2] + q[3]); }
                    PG8_ZERO_ROW(ai, m);
                    float sc = cs;
                    if (nrm) { ss = sum_x32(sum_x16(ss)); sc *= __builtin_amdgcn_rsqf(ss * (1.0f / HD) + EPS); }
                    bf16_t* rowp = base + (size_t)(ai * HALF + m * 16) * QP;
#pragma unroll
                    for (int bj = 0; bj < 2; ++bj) *(v4u*)(rowp + 32 * bj) = lane_t4(pack8(v[bj][0] * sc * gv[bj][0], v[bj][1] * sc * gv[bj][1]), ln_);
                }
        }
    }
};
struct EpiGate {
    bf16_t* gates; LAS const float* rsl; const float* b_gate;
    __device__ __forceinline__ void operator()(Acc& acc, const Unit& u, int wr, int wc, int fr, int fq) const {
        const int row0 = u.pm * BM + wr * 64 + fr;
        float rs[2][4]; rows_rstd(rsl, u, wr, fr, rs);
        const int cg = u.pn * 128 + wc * 32 + 8 * fq;
        f32x4 bs[2], bx[2];
#pragma unroll
        for (int n = 0; n < 2; ++n) { bs[n] = *(const f32x4*)(b_gate + cg + 4 * n); bx[n] = *(const f32x4*)(b_gate + DM + cg + 4 * n); }
        unsigned char* base = (unsigned char*)gates + (size_t)row0 * NGATE + cg * 2;
#pragma unroll
        for (int ai = 0; ai < 2; ++ai)
#pragma unroll
            for (int m = 0; m < 4; ++m) { unsigned char* rowp = base + (size_t)(ai * HALF + m * 16) * NGATE; unsigned qs[2] = {0u, 0u}, qx[2] = {0u, 0u}; const float sc = rs[ai][m] * GATE_INV;
#pragma unroll
                for (int n = 0; n < 2; ++n) { const f32x4 xa = acc[ai][0][m][n] * sc + bs[n], xb_ = acc[ai][1][m][n] * sc + bx[n];
#pragma unroll
                    for (int i = 0; i < 4; ++i) { const float ea = __builtin_amdgcn_exp2f(-LOG2E * xa[i]), eb = __builtin_amdgcn_exp2f(-LOG2E * xb_[i]);
                        qs[n] = __builtin_amdgcn_cvt_pk_u8_f32(__builtin_rintf(255.0f * __builtin_amdgcn_rcpf(1.0f + ea)), i, qs[n]);
                        qx[n] = __builtin_amdgcn_cvt_pk_u8_f32(fmaxf(__builtin_rintf(255.0f * __builtin_amdgcn_rcpf(1.0f + eb)), 1.0f), i, qx[n]); } }
                v4u w; w.x = qs[0]; w.y = qs[1]; w.z = qx[0]; w.w = qx[1]; *(v4u*)rowp = w; PG8_ZERO_ROW(ai, m); }
    }
};
struct EpiOM {
    bf16_t* qkv; const bf16_t* gates;
#define PG8_UB(w, i) ((float)(((w) >> (8 * (i))) & 0xffu))
    __device__ __forceinline__ void mid(Acc& acc, const Unit& u, int wr, int wc, int fr, int fq) const {
        int row0 = u.pm * BM + wr * 64 + fr; const int col0 = u.pn * BM + wc * 32 + 8 * fq;
        asm volatile("" : "+v"(row0));
#pragma unroll
        for (int ai = 0; ai < 2; ++ai) {
            v4u g[4][2];
#pragma unroll
            for (int m = 0; m < 4; ++m)
#pragma unroll
                for (int bj = 0; bj < 2; ++bj) g[m][bj] = *(const v4u*)((const unsigned char*)gates + (size_t)(row0 + ai * HALF + m * 16) * NGATE + (col0 + bj * HALF) * 2);
#pragma unroll
            for (int m = 0; m < 4; ++m)
#pragma unroll
                for (int bj = 0; bj < 2; ++bj) { const v4u gg = g[m][bj]; f32x4& a = acc[ai][bj][m][0]; f32x4& b = acc[ai][bj][m][1];
#pragma unroll
                    for (int i = 0; i < 4; ++i) { a[i] *= PG8_UB(gg.x, i) * __builtin_amdgcn_rcpf(PG8_UB(gg.z, i)); b[i] *= PG8_UB(gg.y, i) * __builtin_amdgcn_rcpf(PG8_UB(gg.w, i)); } }
            asm volatile("" ::: "memory"); }
    }
    __device__ __forceinline__ void operator()(Acc& acc, const Unit& u, int wr, int wc, int fr, int fq) const {
        const int row0 = u.pm * BM + wr * 64 + fr, col0 = u.pn * BM + wc * 32 + 8 * fq;
        v2u g[2][4][2];
#pragma unroll
        for (int ai = 0; ai < 2; ++ai)
#pragma unroll
            for (int m = 0; m < 4; ++m)
#pragma unroll
                for (int bj = 0; bj < 2; ++bj) g[ai][m][bj] = *(const v2u*)((const unsigned char*)gates + (size_t)(row0 + ai * HALF + m * 16) * NGATE + (col0 + bj * HALF) * 2 + 8);
#pragma unroll
        for (int ai = 0; ai < 2; ++ai)
#pragma unroll
            for (int m = 0; m < 4; ++m) { const size_t row = (size_t)(row0 + ai * HALF + m * 16);
#pragma unroll
                for (int bj = 0; bj < 2; ++bj) { const v2u gg = g[ai][m][bj];
                    f32x4 a = acc[ai][bj][m][0], b = acc[ai][bj][m][1];
#pragma unroll
                    for (int i = 0; i < 4; ++i) { a[i] *= PG8_UB(gg.x, i) * (1.0f / 255.0f); b[i] *= PG8_UB(gg.y, i) * (1.0f / 255.0f); }
                    *(v4u*)(qkv + row * QP + 512 + col0 + bj * HALF) = pack8(a, b); } PG8_ZERO_ROW(ai, m); }
    }
#undef PG8_UB
};
template <bool RES_F32, bool X8 = false> struct EpiResT {
    const void* res; bf16_t* xb; float* ssq; unsigned char* xb8; float oscale;
    __device__ __forceinline__ void operator()(Acc& acc, const Unit& u, int wr, int wc, int fr, int fq) const {
        const int row0 = u.pm * BM + wr * 64 + fr, col0 = u.pn * BM + wc * 64 + 8 * fq;
#pragma unroll
        for (int ai = 0; ai < 2; ++ai) {
            f32x4 ra[4][2], rb[4][2];
#pragma unroll
            for (int m = 0; m < 4; ++m)
#pragma unroll
                for (int bj = 0; bj < 2; ++bj) { const size_t o = (size_t)(row0 + ai * HALF + m * 16) * DM + col0 + bj * 32;
                    if (RES_F32) { ra[m][bj] = *(const f32x4*)((const float*)res + o); rb[m][bj] = *(const f32x4*)((const float*)res + o + 4); }
                    else { const v4u t = *(const v4u*)((const bf16_t*)res + o); ra[m][bj] = __builtin_bit_cast(f32x4, (v4u){t.x << 16, t.x & 0xffff0000u, t.y << 16, t.y & 0xffff0000u}); rb[m][bj] = __builtin_bit_cast(f32x4, (v4u){t.z << 16, t.z & 0xffff0000u, t.w << 16, t.w & 0xffff0000u}); } }
            asm volatile("" ::: "memory");
#pragma unroll
            for (int m = 0; m < 4; ++m) { const size_t row = (size_t)(row0 + ai * HALF + m * 16); float ss = 0.f;
#pragma unroll
                for (int bj = 0; bj < 2; ++bj) { const size_t o = row * DM + col0 + bj * 32;
                    const f32x4 a = ra[m][bj] + acc[ai][bj][m][0] * oscale, b = rb[m][bj] + acc[ai][bj][m][1] * oscale;
                    *(v4u*)(xb + o) = pack8(a, b);
                    if (X8) { int lo_ = 0, hi_ = 0; lo_ = __builtin_amdgcn_cvt_pk_fp8_f32(a[0] * X8_SCALE, a[1] * X8_SCALE, lo_, false); lo_ = __builtin_amdgcn_cvt_pk_fp8_f32(a[2] * X8_SCALE, a[3] * X8_SCALE, lo_, true);
                        hi_ = __builtin_amdgcn_cvt_pk_fp8_f32(b[0] * X8_SCALE, b[1] * X8_SCALE, hi_, false); hi_ = __builtin_amdgcn_cvt_pk_fp8_f32(b[2] * X8_SCALE, b[3] * X8_SCALE, hi_, true);
                        *(unsigned long long*)(xb8 + o) = (unsigned long long)(unsigned)lo_ | ((unsigned long long)(unsigned)hi_ << 32); }
                    const f32x4 qa = a * a, qb = b * b; ss += ((qa[0] + qa[1]) + (qa[2] + qa[3])) + ((qb[0] + qb[1]) + (qb[2] + qb[3])); }
                ss = sum_x32(sum_x16(ss));
                if (fq == 0) ssq[row * 16 + u.pn * 4 + wc] = ss; PG8_ZERO_ROW(ai, m); }
        }
    }
};
__device__ __forceinline__ unsigned long long swiglu8_f8(const f32x4 g0, const f32x4 g1, const f32x4 u0, const f32x4 u1, float r) {
    f32x4 a, b; const float r1 = -LOG2E * r, r2 = r * r * ACT_SCALE;
#pragma unroll
    for (int i = 0; i < 4; ++i) { a[i] = (g0[i] * u0[i]) * __builtin_amdgcn_rcpf(1.0f + __builtin_amdgcn_exp2f(g0[i] * r1)) * r2; b[i] = (g1[i] * u1[i]) * __builtin_amdgcn_rcpf(1.0f + __builtin_amdgcn_exp2f(g1[i] * r1)) * r2; }
    int lo = 0, hi = 0; lo = __builtin_amdgcn_cvt_pk_fp8_f32(a[0], a[1], lo, false); lo = __builtin_amdgcn_cvt_pk_fp8_f32(a[2], a[3], lo, true);
    hi = __builtin_amdgcn_cvt_pk_fp8_f32(b[0], b[1], hi, false); hi = __builtin_amdgcn_cvt_pk_fp8_f32(b[2], b[3], hi, true);
    return (unsigned long long)(unsigned)lo | ((unsigned long long)(unsigned)hi << 32);
}
struct EpiUp {
    unsigned char* act; LAS const float* rsl;
    __device__ __forceinline__ void operator()(Acc& acc, const Unit& u, int wr, int wc, int fr, int fq) const {
        const int row0 = u.pm * BM + wr * 64 + fr;
        float rs[2][4]; rows_rstd(rsl, u, wr, fr, rs);
        unsigned char* base = act + (size_t)row0 * DFF + u.pn * 128 + wc * 32 + 8 * fq;
#pragma unroll
        for (int ai = 0; ai < 2; ++ai)
#pragma unroll
            for (int m = 0; m < 4; ++m) { *(unsigned long long*)(base + (size_t)(ai * HALF + m * 16) * DFF) = swiglu8_f8(acc[ai][0][m][0], acc[ai][0][m][1], acc[ai][1][m][0], acc[ai][1][m][1], rs[ai][m]); PG8_ZERO_ROW(ai, m); }
    }
};
struct EpiMoeUp {
    unsigned char* act; LAS const float* rsl;
    __device__ __forceinline__ void operator()(Acc& acc, const Unit& u, int wr, int wc, int fr, int fq) const {
        const int r0 = wr * 64 + fr;
        unsigned char* base = act + (size_t)(u.pm * BM + r0) * DFE8 + u.pn * 128 + wc * 32 + 8 * fq;
#pragma unroll
        for (int ai = 0; ai < 2; ++ai)
#pragma unroll
            for (int m = 0; m < 4; ++m) { const float r = rsl[u.pad * 256 + r0 + ai * HALF + m * 16];
                unsigned char* rp = base + (size_t)(ai * HALF + m * 16) * DFE8;
                *(unsigned long long*)rp = swiglu8_f8(acc[ai][0][m][0], acc[ai][0][m][1], acc[ai][1][m][0], acc[ai][1][m][1], r);
                if (u.pn == DFE / 128 - 1) *(unsigned long long*)(rp + 128) = 0ull; PG8_ZERO_ROW(ai, m); }
    }
};
struct EpiMoeDn {
    bf16_t* y; const float* tok_w; const int* list;
    __device__ __forceinline__ void operator()(Acc& acc, const Unit& u, int wr, int wc, int fr, int fq) const {
        const int r0 = wr * 64 + fr, col0 = u.pn * BM + wc * 32 + 8 * fq;
        int ent[2][4]; float w[2][4];
#pragma unroll
        for (int ai = 0; ai < 2; ++ai)
#pragma unroll
            for (int m = 0; m < 4; ++m) { const int pos = u.pos0 + r0 + ai * HALF + m * 16; ent[ai][m] = -1; w[ai][m] = 0.f;
                if (pos < u.cnt) { ent[ai][m] = list[(size_t)u.e * M + pos]; w[ai][m] = tok_w[(size_t)u.e * M + pos] * DN_INV; } }
        asm volatile("" ::: "memory");
#pragma unroll
        for (int ai = 0; ai < 2; ++ai)
#pragma unroll
            for (int m = 0; m < 4; ++m) {
                if (ent[ai][m] >= 0) { bf16_t* yp = y + (size_t)ent[ai][m] * DM + col0;
#pragma unroll
                    for (int bj = 0; bj < 2; ++bj) *(v4u*)(yp + bj * HALF) = pack8(acc[ai][bj][m][0] * w[ai][m], acc[ai][bj][m][1] * w[ai][m]); } PG8_ZERO_ROW(ai, m); }
    }
};
}
namespace attn {
constexpr int NW = 8, QBLK = 32, QB = 256, KVBLK = 64;
constexpr int NS = 7, SLOTB = 8192, LDS_K = 0, LDS_V = NS * SLOTB, LDS_FB = 2 * NS * SLOTB, LDS_OST = 0  , LDS_WS = 132096  ,
              LDS_SCAN = LDS_WS + NW * 256, LDS_FLAG = LDS_SCAN + 64, LDS_BYTES = LDS_FLAG + 64;
static_assert(LDS_FB + SEQ * 4 <= 131072 && NW * 4096 <= NS * SLOTB, "attention LDS map");
typedef LAS const char* lds_cptr;
typedef short v4i16_t __attribute__((ext_vector_type(4)));
#define ATT_SBAR() __builtin_amdgcn_sched_barrier(0)
#define ATT_WAIT_BAR(N) asm volatile("s_waitcnt vmcnt(" #N ") lgkmcnt(0)\n\ts_barrier" ::: "memory")
#define ATT_MFMA(a, b, c) __builtin_amdgcn_mfma_f32_32x32x16_bf16(a, b, c, 0, 0, 0)
__device__ __forceinline__ int crow(int r, int hi) { return (r & 3) + 8 * (r >> 2) + 4 * hi; }
__device__ __forceinline__ void glds16(const void* g, unsigned lds_base) {
    unsigned sv; asm volatile("s_mov_b32 %0, m0\n\ts_mov_b32 m0, %2\n\ts_nop 0\n\tglobal_load_lds_dwordx4 %1, off\n\ts_mov_b32 m0, %0" : "=&s"(sv) : "v"(g), "s"(lds_base) : "memory"); }
__device__ __forceinline__ void kload8(bf16x8* kf, lds_cptr kpa, lds_cptr kpb) {
    kf[0] = *(const LAS bf16x8*)(kpa); kf[1] = *(const LAS bf16x8*)(kpa + 2048); kf[2] = *(const LAS bf16x8*)(kpb); kf[3] = *(const LAS bf16x8*)(kpb + 2048);
    kf[4] = *(const LAS bf16x8*)(kpa + 4096); kf[5] = *(const LAS bf16x8*)(kpa + 6144); kf[6] = *(const LAS bf16x8*)(kpb + 4096); kf[7] = *(const LAS bf16x8*)(kpb + 6144);
}
__device__ __forceinline__ void pv(f32x16* o, int vb, bf16x8 pa0, bf16x8 pa1, bf16x8 pa2, bf16x8 pa3) {
#pragma unroll
    for (int d0 = 0; d0 < 2; ++d0) { s16x4 lo[4], hi[4];
#pragma unroll
        for (int ks = 0; ks < 4; ++ks) {
            asm volatile("ds_read_b64_tr_b16 %0,%1 offset:%c2" : "=&v"(lo[ks]) : "v"(vb), "i"(d0 * 4096 + ks * 1024) : "memory");
            asm volatile("ds_read_b64_tr_b16 %0,%1 offset:%c2" : "=&v"(hi[ks]) : "v"(vb), "i"(d0 * 4096 + ks * 1024 + 512) : "memory"); }
        asm volatile("s_waitcnt lgkmcnt(0)" ::: "memory"); ATT_SBAR();
#define ATT_PK(k) (bf16x8){lo[k][0], lo[k][1], lo[k][2], lo[k][3], hi[k][0], hi[k][1], hi[k][2], hi[k][3]}
        o[d0] = ATT_MFMA(pa0, ATT_PK(0), o[d0]); o[d0] = ATT_MFMA(pa1, ATT_PK(1), o[d0]); o[d0] = ATT_MFMA(pa2, ATT_PK(2), o[d0]); o[d0] = ATT_MFMA(pa3, ATT_PK(3), o[d0]);
#undef ATT_PK
    }
}
__device__ __forceinline__ float swap_max(float m) { auto rr = __builtin_amdgcn_permlane32_swap(__float_as_uint(m), __float_as_uint(m), false, false); return fmaxf(__uint_as_float(rr[0]), __uint_as_float(rr[1])); }

template <int FOX>
__device__ __forceinline__ int attn_unit(const int b, const int h, const int qb, bf16_t* qkv, const float* logf, LAS char* shm, const int tid, const float qkb, const bool dostore,
                                         const int pre, volatile LAS int* qw, const int nunit, const int xl, const int bxx, const bool vpre) {
    const int lane = tid & 63, r32 = lane & 31, hi = lane >> 5; const int wid = __builtin_amdgcn_readfirstlane(tid >> 6);
    const size_t rowbase = (size_t)b * SEQ; const int q0 = qb * QB, NT = (q0 + QB) / KVBLK;
    const int qc = FOX ? 1536 : 0;
    const bf16_t* Qw = qkv + (rowbase + q0 + wid * QBLK) * QP + qc + h * HD;
    const bf16_t* Kh = qkv + rowbase * QP + qc + 512 + h * HD; const bf16_t* Vh = Kh + 512;
    const unsigned lds0 = (unsigned)(uintptr_t)shm;
    LAS float* wsf = (LAS float*)(shm + LDS_WS) + wid * 64;
    LAS float* Fb = (LAS float*)(shm + LDS_FB);
    LAS unsigned* flags = (LAS unsigned*)(shm + LDS_FLAG);
    const bf16_t* ksrc = Kh + (size_t)(16 * (wid & 3) + (lane >> 2)) * QP + (wid >> 2) * 32 + ((lane & 3) ^ ((lane >> 4) & 3)) * 8;
    const bf16_t* vsrc = Vh + (size_t)(16 * (wid & 3) + (lane >> 2)) * QP + (wid >> 2) * 32 + (lane & 3) * 8;
    const unsigned kdst = lds0 + LDS_K + wid * 1024, vdst = lds0 + LDS_V + wid * 1024;
#define ATT_DMA_K(t, slot) glds16(ksrc + (size_t)(t) * KVBLK * QP, (unsigned)__builtin_amdgcn_readfirstlane(kdst + (slot)))
#define ATT_DMA_V(t, slot) glds16(vsrc + (size_t)(t) * KVBLK * QP, (unsigned)__builtin_amdgcn_readfirstlane(vdst + (slot)))
    const int vb0 = (int)(lds0 + LDS_V) + ((lane >> 4) & 1) * 32 + (lane & 3) * 8 + (4 * hi + ((lane & 15) >> 2)) * 64;
    const int ksw = (r32 >> 2) & 3, kbase = (r32 >> 4) * 1024 + (r32 & 15) * 64;
    const lds_cptr kpA = (lds_cptr)shm + LDS_K + kbase + ((hi ^ ksw) * 16), kpB = (lds_cptr)shm + LDS_K + kbase + (((2 + hi) ^ ksw) * 16);
    bf16x8 qr[4];
#pragma unroll
    for (int d0 = 0; d0 < 4; ++d0) qr[d0] = *reinterpret_cast<const bf16x8*>(&Qw[(size_t)r32 * QP + d0 * 16 + hi * 8]);
    const int qrel = wid * QBLK + r32;
    const int sh = 3 - (wid >> 1);
    if (vpre) { ATT_DMA_K(NT - 1, 0); ATT_DMA_K(NT - 2, SLOTB); ATT_DMA_K(NT - 3, 2 * SLOTB); ATT_DMA_K(NT - 4, 3 * SLOTB); if (NT >= 8) { ATT_DMA_K(NT - 5, 4 * SLOTB); ATT_DMA_K(NT - 6, 5 * SLOTB); } }
    else {
    ATT_DMA_K(NT - 1, 0); ATT_DMA_V(NT - 1, 0); ATT_DMA_K(NT - 2, SLOTB); ATT_DMA_V(NT - 2, SLOTB); ATT_DMA_K(NT - 3, 2 * SLOTB); ATT_DMA_V(NT - 3, 2 * SLOTB); ATT_DMA_K(NT - 4, 3 * SLOTB); ATT_DMA_V(NT - 4, 3 * SLOTB);
    if (NT >= 8) { ATT_DMA_K(NT - 5, 4 * SLOTB); ATT_DMA_V(NT - 5, 4 * SLOTB); ATT_DMA_K(NT - 6, 5 * SLOTB); ATT_DMA_V(NT - 6, 5 * SLOTB); }
    }
    if (FOX) {
        const float* lf = logf + (size_t)(b * NH + h) * SEQ; const int L = q0 + QB, i0 = tid * 8;
        float v[8];
        if (i0 < L) { const f32x4 a = *(const f32x4*)(lf + i0), c = *(const f32x4*)(lf + i0 + 4); v[0] = a.x; v[1] = a.y; v[2] = a.z; v[3] = a.w; v[4] = c.x; v[5] = c.y; v[6] = c.z; v[7] = c.w; }
        else {
#pragma unroll
            for (int k = 0; k < 8; ++k) v[k] = 0.f; }
#pragma unroll
        for (int k = 1; k < 8; ++k) v[k] += v[k - 1];
        float x = v[7];
#pragma unroll
        for (int o = 1; o < 64; o <<= 1) { const float y = __shfl_up(x, o); if (lane >= o) x += y; }
        LAS float* wt = (LAS float*)(shm + LDS_SCAN);
        if (lane == 63) wt[wid] = x;
        asm volatile("s_waitcnt lgkmcnt(0)\n\ts_barrier" ::: "memory");
        float off = x - v[7];
#pragma unroll
        for (int w = 0; w < 8; ++w) off += (w < wid) ? wt[w] : 0.f;
        if (i0 < L) {
#pragma unroll
            for (int k = 0; k < 8; ++k) Fb[i0 + k] = off + v[k]; }
        asm volatile("s_waitcnt lgkmcnt(0)\n\ts_barrier" ::: "memory");
        const float Fq0 = Fb[q0];
        asm volatile("s_waitcnt lgkmcnt(0)\n\ts_barrier" ::: "memory");
        if (i0 < L) {
#pragma unroll
            for (int k = 0; k < 8; ++k) Fb[i0 + k] = (Fq0 - (off + v[k])) * LOG2E; }
        asm volatile("s_waitcnt lgkmcnt(0)\n\ts_barrier" ::: "memory");
    }
    f32x16 o[2]; o[0] = f32x16{}; o[1] = f32x16{};
    float carry = 1.0f;
    float mhat = FOX ? Fb[q0 + qrel] + fminf(qkb, 30.0f) : 0.f;
    float l_reg = 0.f;
    f32x16 pA0, pA1, pB0, pB1;
#define ATT_QK(P0, P1, i_) do { const int t_ = NT - 1 - ((i_) + sh); bf16x8 kf[8]; kload8(kf, kpA + (((i_) + sh) % NS) * SLOTB, kpB + (((i_) + sh) % NS) * SLOTB); f32x16 c0, c1; \
        if (FOX) { _Pragma("unroll") for (int jj = 0; jj < 4; ++jj) { const f32x4 a_ = *(const LAS f32x4*)(Fb + t_ * KVBLK + 8 * jj + 4 * hi), c_ = *(const LAS f32x4*)(Fb + t_ * KVBLK + 32 + 8 * jj + 4 * hi); \
            _Pragma("unroll") for (int k = 0; k < 4; ++k) { c0[4 * jj + k] = a_[k]; c1[4 * jj + k] = c_[k]; } } } else { c0 = f32x16{}; c1 = f32x16{}; } \
        P0 = ATT_MFMA(kf[0], qr[0], c0); P1 = ATT_MFMA(kf[1], qr[0], c1); \
        _Pragma("unroll") for (int d0 = 1; d0 < 4; ++d0) { P0 = ATT_MFMA(kf[2 * d0], qr[d0], P0); P1 = ATT_MFMA(kf[2 * d0 + 1], qr[d0], P1); } } while (0)
    if (NT >= 8) { if (vpre) { ATT_WAIT_BAR(2); } else { ATT_WAIT_BAR(4); } } else { ATT_WAIT_BAR(0); }
    ATT_QK(pA0, pA1, 0);
    bool done = false;
#define ATT_STEP(p0, p1, n0, n1, i, BAND) { \
        if ((i) == 0 && vpre) { if (NT >= 8) { ATT_WAIT_BAR(1); } else { ATT_WAIT_BAR(0); } }        \
        else if ((i) + 5 < NT) { ATT_WAIT_BAR(2); } else { ATT_WAIT_BAR(0); }        \
        if ((i) >= 1) {     \
            const v4u fa = *(const LAS v4u*)(flags + (((i) - 1) & 1) * 8), fb = *(const LAS v4u*)(flags + (((i) - 1) & 1) * 8 + 4); \
            if (__builtin_amdgcn_readfirstlane((int)((fa.x | fa.y) | (fa.z | fa.w) | (fb.x | fb.y) | (fb.z | fb.w))) == 0) { done = true; break; } } \
        if ((i) + 6 < NT) { ATT_DMA_K(NT - 7 - (i), (((i) + 6) % NS) * SLOTB); ATT_DMA_V(NT - 7 - (i), (((i) + 6) % NS) * SLOTB); } \
        const int Lw = (i) + sh; \
        if (Lw + 1 < NT) ATT_QK(n0, n1, (i) + 1); \
        ATT_SBAR(); \
        const int t = NT - 1 - Lw; const bool band = ((i) == 0); const int jb = wid >> 1; \
        if (Lw < NT) {        \
        if (FOX) { \
            if (band) { asm volatile("; band mask" ::: "memory"); _Pragma("unroll") for (int r = 0; r < 16; ++r) { const int kv = 64 * jb + crow(r, hi); if (kv > qrel) p0[r] = -INFINITY; if (kv + 32 > qrel) p1[r] = -INFINITY; } } \
            float sacc = 0.f; \
            _Pragma("unroll") for (int r = 0; r < 16; ++r) { p0[r] = __builtin_amdgcn_exp2f(p0[r] - mhat); p1[r] = __builtin_amdgcn_exp2f(p1[r] - mhat); sacc += p0[r] + p1[r]; } \
            l_reg += sacc; \
        } else { \
              \
            _Pragma("unroll") for (int r = 0; r < 16; ++r) { \
                p0[r] = __builtin_amdgcn_rcpf(1.0f + __builtin_amdgcn_exp2f(-p0[r])); p1[r] = __builtin_amdgcn_rcpf(1.0f + __builtin_amdgcn_exp2f(-p1[r])); } \
            if (band) { asm volatile("; band mask" ::: "memory"); _Pragma("unroll") for (int r = 0; r < 16; ++r) { const int kv = 64 * jb + crow(r, hi); if (kv >= qrel) p0[r] = 0.f; if (kv + 32 >= qrel) p1[r] = 0.f; } }       \
            float G[8], mix[8], pp[8]; \
            _Pragma("unroll") for (int j = 0; j < 4; ++j) { G[j] = ((1.0f - p0[4 * j]) * (1.0f - p0[4 * j + 1])) * ((1.0f - p0[4 * j + 2]) * (1.0f - p0[4 * j + 3])); \
                G[j + 4] = ((1.0f - p1[4 * j]) * (1.0f - p1[4 * j + 1])) * ((1.0f - p1[4 * j + 2]) * (1.0f - p1[4 * j + 3])); } \
            _Pragma("unroll") for (int j = 0; j < 8; ++j) { auto rr = __builtin_amdgcn_permlane32_swap(__float_as_uint(G[j]), __float_as_uint(G[j]), false, false); \
                pp[j] = __uint_as_float(rr[0]) * __uint_as_float(rr[1]); mix[j] = hi ? 1.0f : __uint_as_float(rr[1]); } \
            float P = carry; \
            _Pragma("unroll") for (int j = 7; j >= 0; --j) { \
                const float A = P * mix[j]; P *= pp[j]; \
                f32x16& bb = j < 4 ? p0 : p1; const int r = 4 * (j & 3); \
                const float t3 = A, t2 = t3 * (1.0f - bb[r + 3]), t1 = t2 * (1.0f - bb[r + 2]), t0 = t1 * (1.0f - bb[r + 1]); \
                bb[r + 3] *= t3; bb[r + 2] *= t2; bb[r + 1] *= t1; bb[r] *= t0; } \
            carry = P; \
        } \
        const v4u pw0 = (v4u){cvt_pk_bf16(p0[0], p0[1]), cvt_pk_bf16(p0[2], p0[3]), cvt_pk_bf16(p0[4], p0[5]), cvt_pk_bf16(p0[6], p0[7])}; \
        const v4u pw1 = (v4u){cvt_pk_bf16(p0[8], p0[9]), cvt_pk_bf16(p0[10], p0[11]), cvt_pk_bf16(p0[12], p0[13]), cvt_pk_bf16(p0[14], p0[15])}; \
        const v4u pw2 = (v4u){cvt_pk_bf16(p1[0], p1[1]), cvt_pk_bf16(p1[2], p1[3]), cvt_pk_bf16(p1[4], p1[5]), cvt_pk_bf16(p1[6], p1[7])}; \
        const v4u pw3 = (v4u){cvt_pk_bf16(p1[8], p1[9]), cvt_pk_bf16(p1[10], p1[11]), cvt_pk_bf16(p1[12], p1[13]), cvt_pk_bf16(p1[14], p1[15])}; \
        ATT_SBAR(); \
        pv(o, vb0 + (Lw % NS) * SLOTB, __builtin_bit_cast(bf16x8, pw0), __builtin_bit_cast(bf16x8, pw1), __builtin_bit_cast(bf16x8, pw2), __builtin_bit_cast(bf16x8, pw3)); } \
        { bool live; \
          if (FOX) live = (t > 0) && (qkb + Fb[t * KVBLK - 1] - mhat >= -fminf(150.0f, 70.0f + qkb + fminf(qkb, 30.0f)));     \
          else live = (t > 0) && (carry >= 8.6736174e-19f);     \
          const bool any_live = __any(live); \
          if (lane == 0) flags[((i) & 1) * 8 + wid] = any_live ? 1u : 0u; } }
    for (int i = 0; i < NT; i += 2) {
        ATT_STEP(pA0, pA1, pB0, pB1, i, false)
        ATT_STEP(pB0, pB1, pA0, pA1, i + 1, false)
    }
    (void)done;
#undef ATT_STEP
#undef ATT_QK
    if (tid == 0) qw[0] = pre;
    ATT_WAIT_BAR(0);
    const int un = __builtin_amdgcn_readfirstlane(qw[0]);
    if (un < nunit) {
        const int qbn = 15 - (xl ? (un >> 3) : (un >> 6)), bhn = xl ? (bxx % 8) * NH + (un & 7) : (un & 63), NTn = (qbn * QB + QB) / KVBLK;
        const bf16_t* vn = qkv + (size_t)(bhn / NH) * SEQ * QP + qc + 1024 + (bhn % NH) * HD + (size_t)(16 * (wid & 3) + (lane >> 2)) * QP + (wid >> 2) * 32 + (lane & 3) * 8;
#pragma unroll
        for (int L_ = 0; L_ < 4; ++L_) glds16(vn + (size_t)(NTn - 1 - L_) * KVBLK * QP, (unsigned)__builtin_amdgcn_readfirstlane(vdst + L_ * SLOTB));
        if (NTn >= 8) { glds16(vn + (size_t)(NTn - 5) * KVBLK * QP, (unsigned)__builtin_amdgcn_readfirstlane(vdst + 4 * SLOTB)); glds16(vn + (size_t)(NTn - 6) * KVBLK * QP, (unsigned)__builtin_amdgcn_readfirstlane(vdst + 5 * SLOTB)); }
    }
    float rli[16];
    if (FOX) {
        { auto rr = __builtin_amdgcn_permlane32_swap(__float_as_uint(l_reg), __float_as_uint(l_reg), false, false); l_reg = __uint_as_float(rr[0]) + __uint_as_float(rr[1]); }
        if (hi == 0) wsf[32 + r32] = l_reg;
        asm volatile("s_waitcnt lgkmcnt(0)" ::: "memory");
#pragma unroll
        for (int r = 0; r < 16; ++r) rli[r] = __builtin_amdgcn_rcpf(wsf[32 + crow(r, hi)]);
    } else {
#pragma unroll
        for (int r = 0; r < 16; ++r) rli[r] = 1.0f; }
    bf16_t* Ow = qkv + (rowbase + q0 + wid * QBLK) * QP + qc + h * HD;
    { LAS bf16_t* stg = (LAS bf16_t*)(shm + LDS_OST) + wid * 2048;
#pragma unroll
      for (int r = 0; r < 16; ++r) { const int orow = crow(r, hi);
#pragma unroll
          for (int d0 = 0; d0 < 2; ++d0) stg[orow * 64 + d0 * 32 + r32] = (bf16_t)f2bf(o[d0][r] * rli[r]); }
      asm volatile("s_waitcnt lgkmcnt(0)" ::: "memory");
#pragma unroll
      for (int i = 0; i < 4; ++i) { const int row = i * 8 + (lane >> 3), ch = lane & 7; const v4u v = *(const LAS v4u*)(stg + row * 64 + ch * 8); if (dostore) *(v4u*)(Ow + (size_t)row * QP + ch * 8) = v; } }
    asm volatile("s_waitcnt lgkmcnt(0)\n\ts_barrier" ::: "memory");
#undef ATT_DMA_K
#undef ATT_DMA_V
    return un;
}
}
#define XB_TMO      128
#define XB_XCNT(j)  (256  + 64 * (j))
#define XB_XSUB(j)  (1280 + 64 * (j))
#define XB_XGEN(j)  (2304 + 64 * (j))
#define XB_TOP      3328
#define XB_TOPGEN   3392
#define XB_LFLAG(j) (3456 + 64 * (j))
#define XB_XMIS     5504
#define XCD_BAR_WORDS 5568
#define XB_SPIN_CAP (1u << 18)
__device__ __forceinline__ unsigned xb_ld(unsigned* p)              { return __hip_atomic_load(p, __ATOMIC_RELAXED, __HIP_MEMORY_SCOPE_AGENT); }
__device__ __forceinline__ unsigned xb_add(unsigned* p, unsigned v) { return __hip_atomic_fetch_add(p, v, __ATOMIC_RELAXED, __HIP_MEMORY_SCOPE_AGENT); }
__device__ __forceinline__ unsigned xb_xcc_id() { return (unsigned)__builtin_amdgcn_s_getreg((3 << 11) | 20) & 0xFu; }
#define XB_SPIN(cond, bar) do { unsigned _sp = 0; while (cond) { __builtin_amdgcn_s_sleep(1); \
    if ((++_sp & 255u) == 0u) { if (xb_ld(&(bar)[XB_TMO])) break; if (_sp > XB_SPIN_CAP) { atomicAdd(&(bar)[XB_TMO], 1u); break; } } } } while (0)
struct XcdBarrier { unsigned* bar; unsigned x; volatile LAS unsigned* st; };
__device__ __forceinline__ XcdBarrier xcd_barrier_post(unsigned* bar, volatile LAS unsigned* st) {
    XcdBarrier b; b.bar = bar; b.x = xb_xcc_id(); b.st = st;
    if (threadIdx.x == 0) (void)xb_add(&bar[XB_XCNT(b.x)], 1u);
    return b;
}
__device__ __forceinline__ void xcd_barrier_complete(unsigned* bar, unsigned x, unsigned& nloc, unsigned& nx) {
    const unsigned G = gridDim.x * gridDim.y * gridDim.z;
    unsigned sum, cnt, mine, sp = 0u;
    for (;;) {
        sum = 0u; cnt = 0u; mine = 0u;
#pragma unroll
        for (unsigned j = 0; j < 16; ++j) { const unsigned c = xb_ld(&bar[XB_XCNT(j)]); sum += c; cnt += (c > 0u) ? 1u : 0u; mine = (j == x) ? c : mine; }
        if (sum == G) break;
        __builtin_amdgcn_s_sleep(1);
        if ((++sp & 255u) == 0u) { if (xb_ld(&bar[XB_TMO])) break; if (sp > XB_SPIN_CAP) { atomicAdd(&bar[XB_TMO], 1u); break; } }
    }
    nloc = mine > 0u ? mine : 1u; nx = cnt > 0u ? cnt : 1u;
}
__device__ __forceinline__ void xcd_barrier_impl(unsigned* bar_, unsigned x_, volatile LAS unsigned* st_) {
    asm volatile("" : "+s"(bar_), "+s"(x_) :: "memory");
    XcdBarrier b; b.bar = bar_; b.x = x_; b.st = st_;
    asm volatile("s_waitcnt vmcnt(0)" ::: "memory");
    __syncthreads();
    if (threadIdx.x == 0) {
        unsigned* bar = b.bar;
        __builtin_amdgcn_s_waitcnt(0);
        unsigned nloc = b.st[0], nx = b.st[1];
        if (nloc == 0u) { xcd_barrier_complete(bar, b.x, nloc, nx); b.st[0] = nloc; b.st[1] = nx; }
        const unsigned old = xb_add(&bar[XB_XSUB(b.x)], 1u);
        const unsigned gen = old / nloc;
        if (old + 1u == (gen + 1u) * nloc) {
            __builtin_amdgcn_fence(__ATOMIC_RELEASE, "agent");
            asm volatile("s_waitcnt vmcnt(0)" ::: "memory");
            const unsigned og = xb_add(&bar[XB_TOP], 1u);
            const unsigned tg = og / nx;
            if (og + 1u == (tg + 1u) * nx) xb_add(&bar[XB_TOPGEN], 1u);
            else XB_SPIN(xb_ld(&bar[XB_TOPGEN]) == tg, bar);
            __builtin_amdgcn_fence(__ATOMIC_ACQUIRE, "agent");
            xb_add(&bar[XB_XGEN(b.x)], 1u);
            asm volatile("s_waitcnt vmcnt(0)" ::: "memory");
        } else {
            XB_SPIN(xb_ld(&bar[XB_XGEN(b.x)]) == gen, bar);
            __builtin_amdgcn_fence(__ATOMIC_ACQUIRE, "agent");
            asm volatile("s_waitcnt vmcnt(0)" ::: "memory");
        }
    }
    __syncthreads();
}

__device__ __forceinline__ void xcd_local_barrier(unsigned* bar_, unsigned x_, volatile LAS unsigned* gen_) {
    asm volatile("" : "+s"(bar_), "+s"(x_) :: "memory");
    asm volatile("s_waitcnt vmcnt(0)" ::: "memory");
    __syncthreads();
    if (threadIdx.x < 64) {
        const unsigned lane_ = threadIdx.x, nl = gridDim.x >> 3, rank = blockIdx.x >> 3, gen = gen_[0] + 1u;
        unsigned* fl = bar_ + XB_LFLAG(x_);
        if (lane_ == 0) *(volatile unsigned*)(fl + rank) = gen;
        asm volatile("s_waitcnt vmcnt(0)" ::: "memory");
        unsigned sp_ = 0;
        for (;;) {
            unsigned v = gen; if (lane_ < nl) v = xb_ld(fl + lane_);
            if (__all((int)(v - gen) >= 0)) break;
            __builtin_amdgcn_s_sleep(1);
            if ((++sp_ & 1023u) == 0u) { if (xb_ld(&bar_[XB_TMO])) break; if (sp_ > (XB_SPIN_CAP << 2)) { atomicAdd(&bar_[XB_TMO], 1u); break; } }
        }
        __builtin_amdgcn_fence(__ATOMIC_ACQUIRE, "agent");
        asm volatile("s_waitcnt vmcnt(0)" ::: "memory");
        if (lane_ == 0) gen_[0] = gen;
    }
    __syncthreads();
}

constexpr int CW_ATTQ = 1024;
constexpr int CW_BAR = 4096;
constexpr int RING_BYTES = 131072, MISC_OFF = RING_BYTES + 320, LDS_BYTES = 147456;
constexpr int NPHASE = 15;
struct MkArgs { Ptrs P; int ph_lo, ph_hi, li, pad; };

#define OPAQUE_V(x) asm volatile("" : "+v"(x))
#define OPAQUE_S(x) asm volatile("" : "+s"(x))
__device__ __forceinline__ const float* ldp(LAS unsigned long long* t, int i) { const unsigned long long v = t[i];
    const unsigned lo = __builtin_amdgcn_readfirstlane((unsigned)v), hi = __builtin_amdgcn_readfirstlane((unsigned)(v >> 32)); return (const float*)(((unsigned long long)hi << 32) | lo); }
#define PHASE_BEGIN() int tid = __builtin_amdgcn_readfirstlane((int)WTAB[__builtin_amdgcn_s_getreg(0x2804)]) * 64 + (int)__builtin_amdgcn_mbcnt_hi(~0u, __builtin_amdgcn_mbcnt_lo(~0u, 0u)); asm volatile("" : "+v"(tid) :: "memory"); const int lane = tid & 63, wave = __builtin_amdgcn_readfirstlane(tid >> 6); \
    int G = gridDim.x, bx = blockIdx.x; OPAQUE_S(G); OPAQUE_S(bx); const int vcu = (G % 8 == 0) ? (bx % 8) * (G / 8) + bx / 8 : bx; const int gw = vcu * 8 + wave, ngw = G * 8; \
    Ptrs P; P.x = ldp(ptab, 0); P.g_mix = ldp(ptab, 1); P.w_in = ldp(ptab, 2); P.b_f = ldp(ptab, 3); P.b_gate = ldp(ptab, 4); P.g_q = ldp(ptab, 5); P.g_k = ldp(ptab, 6); P.w_o_sb = ldp(ptab, 7); P.w_o_fox = ldp(ptab, 8); \
    P.w_out = ldp(ptab, 9); P.g_ffn = ldp(ptab, 10); P.w_gu = ldp(ptab, 11); P.w_dn = ldp(ptab, 12); P.w_router = ldp(ptab, 13); P.w_gue = ldp(ptab, 14); P.w_dne = ldp(ptab, 15); P.out = (float*)ldp(ptab, 16); P.ws = (unsigned char*)ldp(ptab, 17); \
    unsigned char* ws = P.ws; \
    bf16_t* xb = (bf16_t*)(ws + WS_XB); bf16_t* qkv = (bf16_t*)(ws + WS_QKV); bf16_t* gates = (bf16_t*)(ws + WS_GATE); float* ssq = (float*)(ws + WS_SSQ); float* logf = (float*)(ws + WS_LOGF); \
    (void)lane; (void)wave; (void)vcu; (void)gw; (void)ngw; (void)xb; (void)qkv; (void)gates; (void)ssq; (void)logf

#ifndef ATT_TY_HI
#define ATT_TY_HI 1
#define ATT_TY_LO 0
#endif
#ifndef STAGGER_TICKS
#define STAGGER_TICKS(us) ((us) * 100)
#endif
#define STAGGER(us) do { } while (0)
#define MK_LOCALS() volatile LAS unsigned* MISC = (volatile LAS unsigned*)(lds + MISC_OFF); LAS unsigned long long* ptab = (LAS unsigned long long*)(lds + MISC_OFF + 128); \
    volatile LAS unsigned* WTAB = (volatile LAS unsigned*)(lds + RING_BYTES); (void)MISC; (void)ptab; (void)WTAB
#define PH_LO() __builtin_amdgcn_readfirstlane((int)MISC[10])
#define PH_HI() __builtin_amdgcn_readfirstlane((int)MISC[11])
#ifndef PH_EN
#define PH_EN 0x7fff
#endif
#define IN(k) (((PH_EN >> (k)) & 1) && PH_LO() <= (k) && (k) < PH_HI())
#ifndef REP_MASK
#define REP_MASK 0
#endif
#define NREP(k) (1 + ((REP_MASK >> (k)) & 1))
#define REP2(k, ...) do { { __VA_ARGS__ } if (NREP(k) > 1) { __VA_ARGS__ } } while (0)
#define SEAM(k) do { if (IN(k) && IN((k) + 1)) xcd_barrier_impl((unsigned*)ldp(ptab, 18), (unsigned)__builtin_amdgcn_readfirstlane((int)MISC[12]), MISC + 8); } while (0)
#define XLOC() __builtin_amdgcn_readfirstlane((int)MISC[13])
#ifdef SEAML2X
#define SEAM_L_EXTRA xcd_local_barrier((unsigned*)ldp(ptab, 18), (unsigned)__builtin_amdgcn_readfirstlane((int)MISC[12]), MISC + 14);
#else
#define SEAM_L_EXTRA
#endif
#define SEAM_L(k) do { if (IN(k) && IN((k) + 1)) { if (XLOC()) { xcd_local_barrier((unsigned*)ldp(ptab, 18), (unsigned)__builtin_amdgcn_readfirstlane((int)MISC[12]), MISC + 14); SEAM_L_EXTRA } else xcd_barrier_impl((unsigned*)ldp(ptab, 18), (unsigned)__builtin_amdgcn_readfirstlane((int)MISC[12]), MISC + 8); } } while (0)


template <int l> __device__ __forceinline__ void layer_phases(LAS unsigned char* lds) {
    MK_LOCALS();
    constexpr int pb = 1 + 6 * l;
        if (IN(pb)) REP2(pb, PHASE_BEGIN();
            if (l == 1) { row_pass_fill<1>(P, (LAS float*)lds, tid); asm volatile("s_waitcnt vmcnt(0) lgkmcnt(0)\n\ts_barrier" ::: "memory"); if (G % 8 == 0) row_pass<1, true>(P, (bx % 8) * (M / 8) + (bx / 8) * 8 + wave, G, lane, (LAS const float*)lds, (bx % 8 + 1) * (M / 8)); else row_pass<1, true>(P, gw, ngw, lane, (LAS const float*)lds);        asm volatile("s_waitcnt lgkmcnt(0)\n\ts_barrier" ::: "memory"); }
            { pg8::StaticOrder S; S.init((const bf16_t*)(ws + WS_WIN) + (size_t)l * NQKV * DM, M / 256, NQKV / 256, DM, G, bx);
              pg8::fill_rstd(lds, ssq, S, tid); pg8::EpiIn E{qkv, (LAS const float*)(lds + pg8::RSL_OFF), P.g_q + l * HD, P.g_k + l * HD};
              pg8::gemm_phase(lds, (const char*)xb, DM, DM, S, E, tid); }
            { pg8::StaticOrder S; S.init((const bf16_t*)((unsigned char*)(ws + WS_WG8) + (size_t)l * NGATE * DM), M / 256, NGATE / 256, DM / 2, G, bx);
              pg8::fill_rstd(lds, ssq, S, tid); pg8::EpiGate E{gates, (LAS const float*)(lds + pg8::RSL_OFF), P.b_gate + l * NGATE};
              pg8::gemm_phase<false, false, true>(lds, (const char*)P.out, DM / 2, DM / 2, S, E, tid); }
        );
        SEAM_L(pb);
        if (IN(pb + 1)) for (int rep_ = 0; rep_ < NREP(pb + 1); ++rep_) { PHASE_BEGIN(); const bool dostore = (rep_ == NREP(pb + 1) - 1);
            float gq = fabsf(P.g_q[l * HD + lane]), gk = fabsf(P.g_k[l * HD + lane]);
#pragma unroll
            for (int o = 1; o < 64; o <<= 1) { gq = fmaxf(gq, __shfl_xor(gq, o)); gk = fmaxf(gk, __shfl_xor(gk, o)); }
            const float qkb = 64.0f * gq * gk * C2 * 1.02f;
            unsigned* qctr = (unsigned*)(ws + WS_CTL) + CW_ATTQ + 128 * l + 256 * rep_;
            volatile LAS int* qs = (volatile LAS int*)(lds + MISC_OFF + 64);
            const int xl = XLOC();
            const int nunit = xl ? NH * 16 : BATCH * NH * 16;
#pragma unroll
            for (int ty = ATT_TY_HI; ty >= ATT_TY_LO; --ty) {
                unsigned* ctr = qctr + 64 * ty + (xl ? 8 * (bx % 8) : 0); int par = 0;
                if (tid == 0) qs[0] = (int)atomicAdd(ctr, 1u);
                asm volatile("s_waitcnt vmcnt(0) lgkmcnt(0)\n\ts_barrier" ::: "memory");
                int u = qs[0]; bool vp = false;
                while (u < nunit) {
                    int pre = 0; if (tid == 0) pre = (int)atomicAdd(ctr, 1u);
                    const int qb = 15 - (xl ? (u >> 3) : (u >> 6)), bh = xl ? (bx % 8) * NH + (u & 7) : (u & 63);
                    int un;
                    if (ty) un = attn::attn_unit<1>(bh / NH, bh % NH, qb, qkv, logf, (LAS char*)lds, tid, qkb, dostore, pre, qs + 1, nunit, xl, bx, vp);
                    else un = attn::attn_unit<0>(bh / NH, bh % NH, qb, qkv, logf, (LAS char*)lds, tid, qkb, dostore, pre, qs + 1, nunit, xl, bx, vp);
                    vp = un < nunit; u = un;
                }
            }
        }
        SEAM_L(pb + 1);
        if (IN(pb + 2)) REP2(pb + 2, PHASE_BEGIN();
            pg8::StaticOrder S; S.init((const bf16_t*)(ws + WS_WOSB) + (size_t)l * DM * DM, M / 256, DM / 256, DM, G, bx); pg8::EpiOM E{qkv, gates};
            pg8::gemm_phase<false, true>(lds, (const char*)qkv, QP, DM, S, E, tid, 8, (size_t)(1536 - 512) * 2);
        );
        SEAM_L(pb + 2);
        if (IN(pb + 3)) REP2((l == 0 ? pb + 3 : 31), PHASE_BEGIN();
            pg8::StaticOrder S; S.init((const bf16_t*)(ws + WS_WOUT) + (size_t)l * DM * DM, M / 256, DM / 256, DM, G, bx);
            if (l == 0) { pg8::EpiResT<true> E{P.x, xb, ssq, nullptr, 1.0f}; pg8::gemm_phase(lds, (const char*)(qkv + 512), QP, DM, S, E, tid); }
            else { pg8::EpiResT<false> E{xb, xb, ssq, nullptr, 1.0f}; pg8::gemm_phase(lds, (const char*)(qkv + 512), QP, DM, S, E, tid); }
        );
        SEAM_L(pb + 3);
        if (l == 0) {
            if (IN(5)) REP2(5, PHASE_BEGIN(); pg8::StaticOrder S; S.init((const bf16_t*)(ws + WS_WGU), M / 256, 2 * DFF / 256, DM, G, bx); pg8::fill_rstd(lds, ssq, S, tid); pg8::EpiUp E{(unsigned char*)qkv, (LAS const float*)(lds + pg8::RSL_OFF)}; STAGGER(9); pg8::gemm_phase(lds, (const char*)xb, DM, DM, S, E, tid); );
            SEAM_L(5);
            if (IN(6)) { PHASE_BEGIN(); pg8::StaticOrder S; S.init((const bf16_t*)(ws + WS_WDN), M / 256, DM / 256, DFF / 2, G, bx); pg8::EpiResT<false, true> E{xb, xb, ssq, (unsigned char*)P.out, DN_INV}; pg8::gemm_phase<false, false, true>(lds, (const char*)qkv, DFF / 2, DFF / 2, S, E, tid);     }
            SEAM_L(6);
        }
    }

__global__ void __launch_bounds__(512, 2) mk_fwd(MkArgs args) {
    extern __shared__ __attribute__((aligned(16))) unsigned char lds_raw[];
    LAS unsigned char* lds = (LAS unsigned char*)lds_raw;
    MK_LOCALS();
    for (int u = threadIdx.x; u < (LDS_BYTES - RING_BYTES) / 4; u += 512) ((LAS unsigned*)(lds + RING_BYTES))[u] = 0u;
    __syncthreads();
    if ((threadIdx.x & 63) == 0) WTAB[__builtin_amdgcn_s_getreg(0x2804)] = threadIdx.x >> 6;
    if (threadIdx.x == 0) { const Ptrs& A = args.P;
        ptab[0] = (unsigned long long)A.x; ptab[1] = (unsigned long long)A.g_mix; ptab[2] = (unsigned long long)A.w_in; ptab[3] = (unsigned long long)A.b_f; ptab[4] = (unsigned long long)A.b_gate; ptab[5] = (unsigned long long)A.g_q;
        ptab[6] = (unsigned long long)A.g_k; ptab[7] = (unsigned long long)A.w_o_sb; ptab[8] = (unsigned long long)A.w_o_fox; ptab[9] = (unsigned long long)A.w_out; ptab[10] = (unsigned long long)A.g_ffn; ptab[11] = (unsigned long long)A.w_gu;
        ptab[12] = (unsigned long long)A.w_dn; ptab[13] = (unsigned long long)A.w_router; ptab[14] = (unsigned long long)A.w_gue; ptab[15] = (unsigned long long)A.w_dne; ptab[16] = (unsigned long long)A.out; ptab[17] = (unsigned long long)A.ws;
        ptab[18] = (unsigned long long)((unsigned*)(A.ws + WS_CTL) + CW_BAR + args.li * XCD_BAR_WORDS); MISC[10] = (unsigned)args.ph_lo; MISC[11] = (unsigned)args.ph_hi; MISC[12] = xb_xcc_id(); }
    __syncthreads();
    if (threadIdx.x == 0 && xb_xcc_id() != (blockIdx.x & 7u)) { (void)xb_add((unsigned*)(args.P.ws + WS_CTL) + CW_BAR + args.li * XCD_BAR_WORDS + XB_XMIS, 1u); asm volatile("s_waitcnt vmcnt(0)" ::: "memory"); }
    (void)xcd_barrier_post((unsigned*)(args.P.ws + WS_CTL) + CW_BAR + args.li * XCD_BAR_WORDS, MISC + 8);
    if (IN(0)) REP2(0, PHASE_BEGIN();
        LAS float* scr = (LAS float*)(lds + wave * 16384);
        for (int it = gw; it < CONV_ITEMS; it += 2 * ngw) {
            int r0_, r1_ = 0; const int j0 = conv_find(it, r0_); const ConvJob c0 = conv_job(P, j0); f32x4 v0[8], v1[8]; conv_load(c0, r0_, lane, v0);
            const bool two = it + ngw < CONV_ITEMS; int j1 = 0; if (two) j1 = conv_find(it + ngw, r1_); const ConvJob c1 = conv_job(P, j1); if (two) conv_load(c1, r1_, lane, v1);
            conv_finish(c0, r0_, scr, lane, v0); if (two) conv_finish(c1, r1_, scr, lane, v1);
        }
        asm volatile("s_waitcnt lgkmcnt(0)\n\ts_barrier" ::: "memory");
        row_pass_fill<0>(P, (LAS float*)lds, tid);
        asm volatile("s_waitcnt vmcnt(0) lgkmcnt(0)\n\ts_barrier" ::: "memory");
        row_pass<0, true>(P, gw, ngw, lane, (LAS const float*)lds);
    );
    SEAM(0);
    if (threadIdx.x == 0) MISC[13] = (gridDim.x % 8 == 0 && xb_ld((unsigned*)ldp(ptab, 18) + XB_XMIS) == 0u) ? 1u : 0u;
    __syncthreads();
    layer_phases<0>(lds);
    layer_phases<1>(lds);
    if (IN(11)) { PHASE_BEGIN(); row_pass_fill<2>(P, (LAS float*)lds, tid); asm volatile("s_waitcnt vmcnt(0) lgkmcnt(0)\n\ts_barrier" ::: "memory"); if (G % 8 == 0) row_pass<2, true>(P, (bx % 8) * (M / 8) + (bx / 8) * 8 + wave, G, lane, (LAS const float*)lds, (bx % 8 + 1) * (M / 8)); else row_pass<2, true>(P, gw, ngw, lane, (LAS const float*)lds); }
    SEAM(11);
    if (IN(12)) REP2(12, PHASE_BEGIN(); pg8::MoeOrder S; S.init(ws, (const bf16_t*)(ws + WS_WGUE), (size_t)2 * DFE * DM * 2, 2 * DFE / 256, DM, G, bx, 1);
        pg8::fill_rstd_moe(lds, (const float*)(ws + WS_RPOS), S, tid); pg8::EpiMoeUp E{(unsigned char*)qkv, (LAS const float*)(lds + pg8::RSL_OFF)}; STAGGER(9); pg8::gemm_phase(lds, (const char*)xb, DM, DM, S, E, tid); );
    SEAM(12);
    if (IN(13)) REP2(13, PHASE_BEGIN(); pg8::MoeOrder S; S.init(ws, (const bf16_t*)(ws + WS_WDNE), (size_t)DM * DFE8, DM / 256, DFE8 / 2, G, bx, 0);
        pg8::EpiMoeDn E{gates, (const float*)(ws + WS_WPOS), (const int*)(ws + WS_LIST)}; pg8::gemm_phase<false, false, true>(lds, (const char*)qkv, DFE8 / 2, DFE8 / 2, S, E, tid); );
    SEAM(13);
    if (IN(14)) { PHASE_BEGIN();
        const size_t stride = (size_t)G * 512 * 4;
        for (size_t i0 = ((size_t)bx * 512 + tid) * 4; i0 < (size_t)M * DM; i0 += 4 * stride) {
            unsigned long long xa[4], ya[4], yb[4];
#pragma unroll
            for (int q = 0; q < 4; ++q) { const size_t i = i0 + q * stride; if (i < (size_t)M * DM) { const size_t m = i / DM, c = i % DM; const bf16_t* y = gates + m * 2 * DM + c;
                xa[q] = *(const unsigned long long*)(xb + i); ya[q] = *(const unsigned long long*)y; yb[q] = *(const unsigned long long*)(y + DM); } }
#pragma unroll
            for (int q = 0; q < 4; ++q) { const size_t i = i0 + q * stride; if (i < (size_t)M * DM) { const unsigned long long x_ = xa[q], a = ya[q], b = yb[q]; f32x4 v;
                v.x = bflo((unsigned)x_) + (bflo((unsigned)a) + bflo((unsigned)b)); v.y = bfhi((unsigned)x_) + (bfhi((unsigned)a) + bfhi((unsigned)b));
                v.z = bflo((unsigned)(x_ >> 32)) + (bflo((unsigned)(a >> 32)) + bflo((unsigned)(b >> 32))); v.w = bfhi((unsigned)(x_ >> 32)) + (bfhi((unsigned)(a >> 32)) + bfhi((unsigned)(b >> 32)));
                *(f32x4*)(P.out + i) = v; } }
        }
    }
}
extern "C" void kernel_launch(void* const* d_in, const int* in_sizes, int n_in, void* d_out, int out_size, void* d_ws, size_t ws_size, hipStream_t stream) {
    if (n_in != 16 || out_size != M * DM || ws_size < WS_END) { fprintf(stderr, "kernel_launch: unexpected shapes n_in %d out %d ws %zu (need %zu)\n", n_in, out_size, ws_size, (size_t)WS_END); return; }
    static int grid = 0;
    if (grid == 0) {
        int dev = 0, cus = 0;
        if (hipGetDevice(&dev) != hipSuccess || hipDeviceGetAttribute(&cus, hipDeviceAttributeMultiprocessorCount, dev) != hipSuccess) { fprintf(stderr, "kernel_launch: device query failed\n"); grid = -1; return; }
        if (hipFuncSetAttribute((const void*)mk_fwd, hipFuncAttributeMaxDynamicSharedMemorySize, LDS_BYTES) != hipSuccess) { fprintf(stderr, "kernel_launch: hipFuncSetAttribute failed\n"); grid = -1; return; }
        int per_cu = 0; if (hipOccupancyMaxActiveBlocksPerMultiprocessor(&per_cu, (const void*)mk_fwd, 512, LDS_BYTES) != hipSuccess || per_cu < 1) fprintf(stderr, "kernel_launch: occupancy query reports %d\n", per_cu);
        (void)hipGetLastError();
        grid = cus;
    }
    if (grid < 0) return;
    Ptrs P{};
    P.x = (const float*)d_in[0]; P.g_mix = (const float*)d_in[1]; P.w_in = (const float*)d_in[2]; P.b_f = (const float*)d_in[3]; P.b_gate = (const float*)d_in[4];
    P.g_q = (const float*)d_in[5]; P.g_k = (const float*)d_in[6]; P.w_o_sb = (const float*)d_in[7]; P.w_o_fox = (const float*)d_in[8]; P.w_out = (const float*)d_in[9];
    P.g_ffn = (const float*)d_in[10]; P.w_gu = (const float*)d_in[11]; P.w_dn = (const float*)d_in[12]; P.w_router = (const float*)d_in[13]; P.w_gue = (const float*)d_in[14]; P.w_dne = (const float*)d_in[15];
    P.out = (float*)d_out; P.ws = (unsigned char*)d_ws;
    (void)hipMemsetAsync((char*)d_ws + WS_CTL, 0, CTL_BYTES, stream);
    MkArgs a{}; a.P = P; a.ph_lo = 0; a.ph_hi = NPHASE; a.li = 0; a.pad = 0;
    hipLaunchKernelGGL(mk_fwd, dim3(grid), dim3(512), LDS_BYTES, stream, a);
}
```

```cpp
#include <hip/hip_runtime.h>
#include <cstdio>
#include <cstdint>
#include <type_traits>

constexpr int DM = 1024, BATCH = 8, SEQ = 4096, M = BATCH * SEQ, NH = 8, HD = 64;
constexpr int DFF = 2816, NE = 8, DFE = 1408, PIN = 5128, NQKV = 3072, NGATE = 2048, NIN = NQKV + NGATE;
constexpr float EPS = 1e-6f;
constexpr float LOG2E = 1.4426950408889634f, LN2 = 0.6931471805599453f;
constexpr float C2 = 0.125f * LOG2E;
constexpr int QP = NQKV;
constexpr int MPAD = 2 * M + NE * 256;
constexpr float ACT_SCALE = 16.0f, WDN_SCALE = 1024.0f, DN_INV = 1.0f / (16.0f * 1024.0f);
constexpr float X8_SCALE = 8.0f, WG_SCALE = 1024.0f, GATE_INV = 1.0f / (8.0f * 1024.0f);
constexpr int DFE8 = 1536;

constexpr size_t MiB = 1u << 20;
constexpr size_t WS_CTL = 0, CTL_BYTES = 1 * MiB;
constexpr size_t WS_WIN = 1 * MiB;
constexpr size_t WS_WG8 = 13 * MiB;
constexpr size_t WS_WOSB = 21 * MiB;
constexpr size_t WS_WOFX = 23 * MiB;
constexpr size_t WS_WOUT = 25 * MiB;
constexpr size_t WS_WGU = 29 * MiB;
constexpr size_t WS_WDN = 40 * MiB;
constexpr size_t WS_WGUE = 46 * MiB;
constexpr size_t WS_WDNE = 90 * MiB;
constexpr size_t WS_XB = 112 * MiB;
constexpr size_t WS_QKV = 176 * MiB;
constexpr size_t WS_GATE = 368 * MiB;
constexpr size_t WS_SSQ = 496 * MiB;
constexpr size_t WS_LOGF = 498 * MiB;
constexpr size_t WS_CUMF = 499 * MiB;
constexpr size_t WS_RSTD = 500 * MiB;
constexpr size_t WS_TOKE = 500 * MiB + 256 * 1024;
constexpr size_t WS_TOKW = 500 * MiB + 512 * 1024;
constexpr size_t WS_LIST = 501 * MiB;
constexpr size_t WS_RPOS = 502 * MiB;
constexpr size_t WS_WPOS = 503 * MiB;
constexpr size_t WS_END = 504 * MiB;
constexpr int CW_MOECNT = 64;

typedef unsigned short bf16_t;
typedef unsigned v4u __attribute__((ext_vector_type(4)));
typedef unsigned v2u __attribute__((ext_vector_type(2)));
typedef float f32x4 __attribute__((ext_vector_type(4)));
typedef float f32x2 __attribute__((ext_vector_type(2)));
__device__ __forceinline__ unsigned cvt_pk_bf16(float lo, float hi) { typedef __bf16 bf2 __attribute__((ext_vector_type(2))); f32x2 v = {lo, hi}; bf2 b = __builtin_convertvector(v, bf2); return __builtin_bit_cast(unsigned, b); }

__device__ __forceinline__ unsigned f2bf(float f) { unsigned u = __builtin_bit_cast(unsigned, f); return (u + 0x7fffu + ((u >> 16) & 1u)) >> 16; }
__device__ __forceinline__ unsigned pk2(float lo, float hi) { return f2bf(lo) | (f2bf(hi) << 16); }
__device__ __forceinline__ float bf2f(bf16_t b) { return __builtin_bit_cast(float, (unsigned)b << 16); }
#define DPP_ADD_(v, ctrl) ((v) + __builtin_bit_cast(float, __builtin_amdgcn_update_dpp(0, __builtin_bit_cast(int, (v)), (ctrl), 0xF, 0xF, true)))
__device__ __forceinline__ float sum_x16(float v) { auto rr = __builtin_amdgcn_permlane16_swap(__float_as_uint(v), __float_as_uint(v), false, false); return __uint_as_float(rr[0]) + __uint_as_float(rr[1]); }
__device__ __forceinline__ float sum_x32(float v) { auto rr = __builtin_amdgcn_permlane32_swap(__float_as_uint(v), __float_as_uint(v), false, false); return __uint_as_float(rr[0]) + __uint_as_float(rr[1]); }
__device__ __forceinline__ float sum_quad(float v) { v = DPP_ADD_(v, 0xB1); v = DPP_ADD_(v, 0x4E); return v; }
__device__ __forceinline__ float wave_sum(float v) {
    v = sum_quad(v); v = DPP_ADD_(v, 0x141); v = DPP_ADD_(v, 0x140);
    return sum_x32(sum_x16(v));
}
__device__ __forceinline__ float sigmoidf_(float x) { return 1.f / (1.f + __expf(-x)); }

struct Ptrs {
    const float *x, *g_mix, *w_in, *b_f, *b_gate, *g_q, *g_k, *w_o_sb, *w_o_fox, *w_out, *g_ffn, *w_gu, *w_dn, *w_router, *w_gue, *w_dne;
    float* out; unsigned char* ws;
};

__host__ __device__ __forceinline__ int colperm(int s) { return ((s & 127) >> 5) * 64 + (s >> 7) * 32 + (s & 31); }
struct ConvJob { const float* src; bf16_t* dst; const float* gain; int K, ld, NB, map, hid, dpitch, dk0, f8, Kd; };
__device__ __forceinline__ int conv_src_col(const ConvJob& j, int db) {
    if (j.map == 0) return 32 * db;
    const int t = db >> 3, sb = db & 7;
    if (j.map == 1) return t * 256 + colperm(32 * sb);
    if (j.map == 4) return NQKV + 8 + (sb < 4 ? 128 * t + 32 * sb : DM + 128 * t + 32 * (sb - 4));
    if (j.map == 3) return t * 256 + colperm(32 * sb);
    return sb < 4 ? 128 * t + 32 * sb : j.hid + 128 * t + 32 * (sb - 4);
}
__device__ __forceinline__ ConvJob conv_job(const Ptrs& P, int j) {
    ConvJob c; unsigned char* ws = P.ws; c.dk0 = 0; c.dpitch = 0; c.f8 = 0; c.Kd = 0;
    if (j < 2) { c.src = P.w_in + (size_t)j * DM * PIN; c.dst = (bf16_t*)(ws + WS_WIN) + (size_t)j * NQKV * DM; c.gain = P.g_mix + j * DM; c.K = DM; c.ld = PIN; c.NB = NQKV / 32; c.map = 1; c.hid = 0; return c; }
    if (j >= 26) { const int l = j - 26; c.src = P.w_in + (size_t)l * DM * PIN; c.dst = (bf16_t*)((unsigned char*)(ws + WS_WG8) + (size_t)l * NGATE * DM); c.gain = P.g_mix + l * DM; c.K = DM; c.ld = PIN; c.NB = NGATE / 32; c.map = 4; c.hid = 0; c.f8 = 1; c.Kd = DM; return c; }
    if (j < 4) { const int l = j - 2; c.src = P.w_o_sb + (size_t)l * 512 * DM; c.dst = (bf16_t*)(ws + WS_WOSB) + (size_t)l * DM * DM; c.gain = nullptr; c.K = 512; c.ld = DM; c.NB = DM / 32; c.map = 0; c.hid = 0; c.dpitch = DM; c.dk0 = 0; return c; }
    if (j < 6) { const int l = j - 4; c.src = P.w_o_fox + (size_t)l * 512 * DM; c.dst = (bf16_t*)(ws + WS_WOSB) + (size_t)l * DM * DM; c.gain = nullptr; c.K = 512; c.ld = DM; c.NB = DM / 32; c.map = 0; c.hid = 0; c.dpitch = DM; c.dk0 = 512; return c; }
    if (j < 8) { const int l = j - 6; c.src = P.w_out + (size_t)l * DM * DM; c.dst = (bf16_t*)(ws + WS_WOUT) + (size_t)l * DM * DM; c.gain = nullptr; c.K = DM; c.ld = DM; c.NB = DM / 32; c.map = 3; c.hid = 0; return c; }
    if (j == 8) { c.src = P.w_gu; c.dst = (bf16_t*)(ws + WS_WGU); c.gain = P.g_ffn; c.K = DM; c.ld = 2 * DFF; c.NB = 2 * DFF / 32; c.map = 2; c.hid = DFF; return c; }
    if (j == 9) { c.src = P.w_dn; c.dst = (bf16_t*)(ws + WS_WDN); c.gain = nullptr; c.K = DFF; c.ld = DM; c.NB = DM / 32; c.map = 3; c.hid = 0; c.f8 = 1; c.Kd = DFF; return c; }
    if (j < 18) { const int e = j - 10; c.src = P.w_gue + (size_t)e * DM * 2 * DFE; c.dst = (bf16_t*)(ws + WS_WGUE) + (size_t)e * 2 * DFE * DM; c.gain = P.g_ffn + DM; c.K = DM; c.ld = 2 * DFE; c.NB = 2 * DFE / 32; c.map = 2; c.hid = DFE; return c; }
    { const int e = j - 18; c.src = P.w_dne + (size_t)e * DFE * DM; c.dst = (bf16_t*)((unsigned char*)(ws + WS_WDNE) + (size_t)e * DM * DFE8); c.gain = nullptr; c.K = DFE; c.ld = DM; c.NB = DM / 32; c.map = 0; c.hid = 0; c.f8 = 1; c.Kd = DFE8; return c; }
}
constexpr int NJOBS = 28;
__host__ __device__ constexpr int conv_job_items(int j) {
    return j >= 26 ? (DM / 64) * (NGATE / 32) : j < 2 ? (DM / 64) * (NQKV / 32) : j < 6 ? (512 / 64) * (DM / 32) : j < 8 ? (DM / 64) * (DM / 32) : j == 8 ? (DM / 64) * (2 * DFF / 32) : j == 9 ? (DFF / 64) * (DM / 32)
         : j < 18 ? (DM / 64) * (2 * DFE / 32) : (DFE8 / 64) * (DM / 32);
}
__host__ __device__ constexpr int conv_items_before(int j) { int s = 0; for (int i = 0; i < j; ++i) s += conv_job_items(i); return s; }
constexpr int CONV_ITEMS = conv_items_before(NJOBS);
__device__ __forceinline__ void conv_load(const ConvJob& j, int item, int lane, f32x4 (&v)[8]) {
    const int kb = item / j.NB, db = item % j.NB, k0 = 64 * kb, sc = conv_src_col(j, db);
    const int r0 = lane >> 3, c4 = (lane & 7) * 4;
    if (j.f8) {
        if (k0 < j.K) {
#pragma unroll
            for (int i = 0; i < 2; ++i) { const int q = r0 + 8 * i;
#pragma unroll
                for (int t = 0; t < 4; ++t) v[4 * i + t] = *(const f32x4*)(j.src + (size_t)(k0 + 4 * q + t) * j.ld + sc + c4); } }
        else {
#pragma unroll
            for (int i = 0; i < 8; ++i) v[i] = (f32x4){0.f, 0.f, 0.f, 0.f}; }
        return; }
#pragma unroll
    for (int i = 0; i < 4; ++i) { const int q = r0 + 8 * i; v[2 * i] = *(const f32x4*)(j.src + (size_t)(k0 + 2 * q) * j.ld + sc + c4); v[2 * i + 1] = *(const f32x4*)(j.src + (size_t)(k0 + 2 * q + 1) * j.ld + sc + c4); }
}
template <class LP> __device__ __forceinline__ void conv_finish(const ConvJob& j, int item, LP scr, int lane, const f32x4 (&v)[8]) {
    const int kb = item / j.NB, db = item % j.NB, k0 = 64 * kb;
    const int r0 = lane >> 3, c4 = (lane & 7) * 4;
    auto scr32 = (decltype(scr))scr;
    if (j.f8) {
#pragma unroll
        for (int i = 0; i < 2; ++i) { const int q = r0 + 8 * i;
            const float g0 = (j.gain ? j.gain[k0 + 4 * q] : 1.0f) * WDN_SCALE, g1 = (j.gain ? j.gain[k0 + 4 * q + 1] : 1.0f) * WDN_SCALE, g2 = (j.gain ? j.gain[k0 + 4 * q + 2] : 1.0f) * WDN_SCALE, g3 = (j.gain ? j.gain[k0 + 4 * q + 3] : 1.0f) * WDN_SCALE;
#pragma unroll
            for (int c = 0; c < 4; ++c) { int w = 0; w = __builtin_amdgcn_cvt_pk_fp8_f32(v[4 * i][c] * g0, v[4 * i + 1][c] * g1, w, false); w = __builtin_amdgcn_cvt_pk_fp8_f32(v[4 * i + 2][c] * g2, v[4 * i + 3][c] * g3, w, true);
                scr32[(c4 + c) * 18 + q] = __builtin_bit_cast(float, w); } }
        asm volatile("s_waitcnt lgkmcnt(0)" ::: "memory");
        const int ch = lane & 3;
#pragma unroll
        for (int jj = 0; jj < 2; ++jj) { const int n = (lane >> 2) + 16 * jj; auto s = scr32 + n * 18 + 4 * ch;
            v4u o; o.x = __builtin_bit_cast(unsigned, s[0]); o.y = __builtin_bit_cast(unsigned, s[1]); o.z = __builtin_bit_cast(unsigned, s[2]); o.w = __builtin_bit_cast(unsigned, s[3]);
            *(v4u*)((unsigned char*)j.dst + (size_t)(32 * db + n) * j.Kd + k0 + 16 * ch) = o; }
        asm volatile("s_waitcnt lgkmcnt(0)" ::: "memory");
        return; }
#pragma unroll
    for (int i = 0; i < 4; ++i) { const int q = r0 + 8 * i; const float g0 = j.gain ? j.gain[k0 + 2 * q] : 1.0f, g1 = j.gain ? j.gain[k0 + 2 * q + 1] : 1.0f;
#pragma unroll
        for (int c = 0; c < 4; ++c) scr32[(c4 + c) * 34 + q] = __builtin_bit_cast(float, cvt_pk_bf16(v[2 * i][c] * g0, v[2 * i + 1][c] * g1)); }
    asm volatile("s_waitcnt lgkmcnt(0)" ::: "memory");
    const int c = lane & 7;
#pragma unroll
    for (int jj = 0; jj < 4; ++jj) { const int n = (lane >> 3) + 8 * jj; auto s = scr32 + n * 34 + 4 * c;
        v4u o; o.x = __builtin_bit_cast(unsigned, s[0]); o.y = __builtin_bit_cast(unsigned, s[1]); o.z = __builtin_bit_cast(unsigned, s[2]); o.w = __builtin_bit_cast(unsigned, s[3]);
        *(v4u*)(j.dst + (size_t)(32 * db + n) * (j.dpitch ? j.dpitch : j.K) + j.dk0 + k0 + 8 * c) = o; }
    asm volatile("s_waitcnt lgkmcnt(0)" ::: "memory");
}
template <class LP> __device__ __forceinline__ void conv_item(const ConvJob& j, int item, LP scr, int lane) { f32x4 v[8]; conv_load(j, item, lane, v); conv_finish(j, item, scr, lane, v); }
__device__ __forceinline__ int conv_find(int it, int& r) { int j = 0; r = it;
#pragma unroll 1
    for (; j < NJOBS; ++j) { const int n = conv_job_items(j); if (r < n) break; r -= n; }
    return j; }
__device__ __forceinline__ void conv_dispatch(const Ptrs& P, int it, float* scr, int lane) {
    int j = 0, r = it;
#pragma unroll 1
    for (; j < NJOBS; ++j) { const int n = conv_job_items(j); if (r < n) break; r -= n; }
    const ConvJob c = conv_job(P, j); conv_item(c, r, scr, lane);
}

#ifndef LAS
#define LAS __attribute__((address_space(3)))
#endif
template <int MODE> __device__ __forceinline__ void row_pass_fill(const Ptrs& P, LAS float* wt, int tid) {
    const int l = MODE == 0 ? 0 : 1;
    const float* W = MODE == 2 ? P.w_router : P.w_in + (size_t)l * DM * PIN + NQKV; const int ld = MODE == 2 ? NE : PIN;
    const float* g = MODE == 2 ? P.g_ffn + DM : P.g_mix + l * DM;
    float wv[16], gv[16];
#pragma unroll
    for (int it = 0; it < 8 * DM / 512; ++it) { const int i = tid + 512 * it, k = i >> 3, e = i & 7; wv[it] = W[(size_t)k * ld + e]; gv[it] = g[k]; }
#pragma unroll
    for (int it = 0; it < 8 * DM / 512; ++it) { const int i = tid + 512 * it, k = i >> 3, e = i & 7; wt[e * DM + k] = wv[it] * gv[it]; }
}
template <int MODE, bool WLDS = false> __device__ __forceinline__ void row_pass(const Ptrs& P, int gw, int ngw, int lane, LAS const float* wt = nullptr, int mend = M) {
    unsigned char* ws = P.ws;
    const float* res = P.x; const bf16_t* resb = (const bf16_t*)(P.ws + WS_XB);
    const int l = MODE == 0 ? 0 : 1;
    float w[8][16];
    if (!WLDS) {
        const float* W = MODE == 2 ? P.w_router : P.w_in + (size_t)l * DM * PIN + NQKV; const int ld = MODE == 2 ? NE : PIN;
        const float* g = MODE == 2 ? P.g_ffn + DM : P.g_mix + l * DM;
#pragma unroll
        for (int j = 0; j < 4; ++j)
#pragma unroll
            for (int c = 0; c < 4; ++c) { const int k = 4 * lane + 256 * j + c; const float gk = g[k];
#pragma unroll
                for (int e = 0; e < 8; ++e) w[e][4 * j + c] = W[(size_t)k * ld + e] * gk; }
    }
    float bfv[8];
#pragma unroll
    for (int e = 0; e < 8; ++e) bfv[e] = MODE == 2 ? 0.f : P.b_f[l * NH + e];
    float* logf = (float*)(ws + WS_LOGF);
    int ent_e = -1, ent_v = 0, nent = 0; float ent_r = 0.f, ent_w = 0.f;
    unsigned* cnt = (unsigned*)(ws + WS_CTL) + CW_MOECNT; int* list = (int*)(ws + WS_LIST);
#define ROUTER_FLUSH() do {     \
        unsigned long long mk_ = 0ull; int cn_ = 0; \
        _Pragma("unroll") for (int e_ = 0; e_ < NE; ++e_) { const unsigned long long m_ = __ballot(ent_e == e_); if (ent_e == e_) mk_ = m_; if (lane == e_) cn_ = __popcll(m_); } \
        unsigned base_ = 0; if (lane < NE && cn_ > 0) base_ = atomicAdd(cnt + lane, (unsigned)cn_); \
        const unsigned mybase_ = (unsigned)__shfl((int)base_, ent_e < 0 ? 0 : ent_e); \
        if (ent_e >= 0) { const int rank = __popcll(mk_ & ((1ull << lane) - 1ull)); const size_t o_ = (size_t)ent_e * M + mybase_ + rank; \
            list[o_] = ent_v; ((float*)(ws + WS_RPOS))[o_] = ent_r; ((float*)(ws + WS_WPOS))[o_] = ent_w; } \
        ent_e = -1; nent = 0; } while (0)
    typedef typename std::conditional<MODE == 0, f32x4, unsigned long long>::type raw_t;
    raw_t r1[4], r2[4];
#define ROW_LOAD(dst_, m_) do { if constexpr (MODE == 0) { _Pragma("unroll") for (int j = 0; j < 4; ++j) dst_[j] = ((const f32x4*)(res + (size_t)(m_) * DM) + lane)[64 * j]; } \
        else { _Pragma("unroll") for (int j = 0; j < 4; ++j) dst_[j] = ((const unsigned long long*)(resb + (size_t)(m_) * DM) + lane)[64 * j]; } } while (0)
    if (gw < mend) ROW_LOAD(r1, gw);
    if (gw + ngw < mend) ROW_LOAD(r2, gw + ngw);
    auto row_body = [&](const int m, raw_t (&R)[4]) __attribute__((always_inline)) {
        f32x4 v[4]; float s = 0.f;
#pragma unroll
        for (int j = 0; j < 4; ++j) {
            if constexpr (MODE == 0) v[j] = R[j];
            else { const unsigned long long t_ = R[j]; v[j] = (f32x4){__builtin_bit_cast(float, (unsigned)t_ << 16), __builtin_bit_cast(float, (unsigned)t_ & 0xffff0000u), __builtin_bit_cast(float, (unsigned)(t_ >> 32) << 16), __builtin_bit_cast(float, (unsigned)(t_ >> 32) & 0xffff0000u)}; }
            s = fmaf(v[j].x, v[j].x, s); s = fmaf(v[j].y, v[j].y, s); s = fmaf(v[j].z, v[j].z, s); s = fmaf(v[j].w, v[j].w, s); }
        if (m + 2 * ngw < mend) ROW_LOAD(R, m + 2 * ngw);
        s = wave_sum(s);
        float d[8];
#pragma unroll
        for (int e = 0; e < 8; ++e) { float a = 0.f;
#pragma unroll
            for (int j = 0; j < 4; ++j) { f32x4 ww; if (WLDS) ww = *(const LAS f32x4*)(wt + e * DM + 4 * lane + 256 * j); else ww = (f32x4){w[e][4 * j], w[e][4 * j + 1], w[e][4 * j + 2], w[e][4 * j + 3]};
                a = fmaf(v[j].x, ww.x, a); a = fmaf(v[j].y, ww.y, a); a = fmaf(v[j].z, ww.z, a); a = fmaf(v[j].w, ww.w, a); }
            d[e] = wave_sum(a); }
        const float rstd = __builtin_amdgcn_rsqf(s * (1.0f / DM) + EPS);
        if (MODE == 0) {
            unsigned long long* o8 = (unsigned long long*)((bf16_t*)(ws + WS_XB) + (size_t)m * DM) + lane;
#pragma unroll
            for (int j = 0; j < 4; ++j) o8[64 * j] = (unsigned long long)cvt_pk_bf16(v[j].x, v[j].y) | ((unsigned long long)cvt_pk_bf16(v[j].z, v[j].w) << 32);
            unsigned* o4 = (unsigned*)((unsigned char*)P.out + (size_t)m * DM) + lane;
#pragma unroll
            for (int j = 0; j < 4; ++j) { int w_ = 0; w_ = __builtin_amdgcn_cvt_pk_fp8_f32(v[j].x * X8_SCALE, v[j].y * X8_SCALE, w_, false); w_ = __builtin_amdgcn_cvt_pk_fp8_f32(v[j].z * X8_SCALE, v[j].w * X8_SCALE, w_, true); o4[64 * j] = (unsigned)w_; }
            if (lane < 16) ((float*)(ws + WS_SSQ))[(size_t)m * 16 + lane] = lane == 0 ? s : 0.f;
        }
        if (MODE != 2) {
            float z = 0.f;
#pragma unroll
            for (int e = 0; e < 8; ++e) { const float ze = d[e] * rstd + bfv[e]; if (lane == e) z = ze; }
            const float val = fminf(z, 0.f) - log1pf(__expf(-fabsf(z)));
            const int b = m / SEQ, sp = m % SEQ;
            if (lane < 8) logf[(size_t)(b * NH + lane) * SEQ + sp] = val;
        } else {
            int e0 = 0; float v0 = d[0] * rstd;
#pragma unroll
            for (int e = 1; e < 8; ++e) { const float t = d[e] * rstd; if (t > v0) { v0 = t; e0 = e; } }
            int e1 = -1; float v1 = -INFINITY;
#pragma unroll
            for (int e = 0; e < 8; ++e) { const float t = d[e] * rstd; if (e != e0 && t > v1) { v1 = t; e1 = e; } }
            const float w1 = 1.f / (1.f + __expf(v0 - v1)), w0 = 1.f - w1;
            if (lane == 0) { ((float*)(ws + WS_RSTD))[m] = rstd; ((int*)(ws + WS_TOKE))[2 * m] = e0; ((int*)(ws + WS_TOKE))[2 * m + 1] = e1;
                ((float*)(ws + WS_TOKW))[2 * m] = w0; ((float*)(ws + WS_TOKW))[2 * m + 1] = w1; }
            if (lane == nent) { ent_e = e0; ent_v = 2 * m; ent_r = rstd; ent_w = w0; } if (lane == nent + 1) { ent_e = e1; ent_v = 2 * m + 1; ent_r = rstd; ent_w = w1; }
            nent += 2; if (nent == 64) ROUTER_FLUSH();
        }
    };
    for (int m = gw; m < mend; m += 2 * ngw) { row_body(m, r1); if (m + ngw < mend) row_body(m + ngw, r2); }
    if (MODE == 2) {
        LAS unsigned* wc = (LAS unsigned*)(wt + 8 * DM);
        const int wv = gw & 7;
        unsigned long long mk_ = 0ull; int cn_ = 0;
#pragma unroll
        for (int e_ = 0; e_ < NE; ++e_) { const unsigned long long m_ = __ballot(ent_e == e_); if (ent_e == e_) mk_ = m_; if (lane == e_) cn_ = __popcll(m_); }
        if (lane < NE) wc[wv * 8 + lane] = (unsigned)cn_;
        asm volatile("s_waitcnt lgkmcnt(0)\n\ts_barrier" ::: "memory");
        if (wv == 0 && lane < NE) { unsigned tot = 0;
#pragma unroll
            for (int w_ = 0; w_ < 8; ++w_) tot += wc[w_ * 8 + lane];
            unsigned base_ = 0; if (tot > 0) base_ = atomicAdd(cnt + lane, tot); wc[64 + lane] = base_; }
        asm volatile("s_waitcnt vmcnt(0) lgkmcnt(0)\n\ts_barrier" ::: "memory");
        unsigned base_ = 0;
        if (lane < NE) { base_ = wc[64 + lane];
#pragma unroll
            for (int w_ = 0; w_ < 8; ++w_) base_ += (w_ < wv) ? wc[w_ * 8 + lane] : 0u; }
        const unsigned mybase_ = (unsigned)__shfl((int)base_, ent_e < 0 ? 0 : ent_e);
        if (ent_e >= 0) { const int rank = __popcll(mk_ & ((1ull << lane) - 1ull)); const size_t o_ = (size_t)ent_e * M + mybase_ + rank;
            list[o_] = ent_v; ((float*)(ws + WS_RPOS))[o_] = ent_r; ((float*)(ws + WS_WPOS))[o_] = ent_w; }
    }
#undef ROUTER_FLUSH
#undef ROW_LOAD
}

struct MoeLoc { int e, pos, cnt, total; };
__device__ __forceinline__ MoeLoc moe_locate(const unsigned char* ws, int v) {
    const unsigned* cnt = (const unsigned*)(ws + WS_CTL) + CW_MOECNT; int b = 0; MoeLoc L; L.e = 0; L.pos = 0; L.cnt = 0;
#pragma unroll
    for (int e = 0; e < NE; ++e) { const int c = (int)__hip_atomic_load(cnt + e, __ATOMIC_RELAXED, __HIP_MEMORY_SCOPE_AGENT); if (v >= b) { L.e = e; L.pos = v - b; L.cnt = c; } b += (c + 255) & ~255; }
    L.total = b; return L;
}

#ifndef LAS
#define LAS __attribute__((address_space(3)))
#endif
typedef short bf16x8 __attribute__((ext_vector_type(8)));
typedef float f32x16 __attribute__((ext_vector_type(16)));
typedef short s16x4 __attribute__((ext_vector_type(4)));

__device__ __forceinline__ float fast_sigmoid(float x) { return __builtin_amdgcn_rcpf(1.0f + __builtin_amdgcn_exp2f(-LOG2E * x)); }
__device__ __forceinline__ float bflo(unsigned u) { return __builtin_bit_cast(float, u << 16); }
__device__ __forceinline__ float bfhi(unsigned u) { return __builtin_bit_cast(float, u & 0xffff0000u); }

#ifndef PG8_ALIGN_EPI
#define PG8_ALIGN_EPI 1
#endif
namespace pg8 {
constexpr int BM = 256, BK = 64, HALF = 128, HTB = HALF * BK * 2, STAGE_BYTES = 8 * HTB, NXCD = 8, WGM = 8;
__device__ __forceinline__ int lds_byte(int r, int c) { return (r >> 3) * 1024 + (r & 7) * 128 + ((((c >> 3) ^ (r >> 1)) & 7) << 4) + (c & 7) * 2; }
__device__ __forceinline__ void stage_rc(int b, int& R, int& C) { const int st = b / 1024, sb = b % 1024; R = st * 8 + sb / 128; C = ((((sb % 128) >> 4) ^ (R >> 1)) & 7) * 8; }
__device__ __forceinline__ int perm32(int rho) { const int n = rho >> 4, i = rho & 15; return 8 * (i >> 2) + 4 * n + (i & 3); }

struct Unit { const char* b; int pm, pn, e, pos0, cnt, pad; };

struct StaticOrder {
    const char* Bt; int nM, nN, nwg, G, c, K;
    __device__ void init(const bf16_t* Bt_, int nM_, int nN_, int K_, int G_, int c_) { Bt = (const char*)Bt_; nM = nM_; nN = nN_; nwg = nM * nN; G = G_; c = c_; K = K_; }
    __device__ bool next(int i, Unit& u) const {
        const long L = (long)i * G + c; if (L >= nwg) return false;
        int wgid = (int)L; { const int q = nwg / NXCD, r = nwg % NXCD, xcd = wgid % NXCD, off = wgid / NXCD; wgid = (xcd < r ? xcd * (q + 1) : r * (q + 1) + (xcd - r) * q) + off; }
        const int nig = WGM * nN, gid = wgid / nig, fm = gid * WGM, gsz = (nM - fm) < WGM ? (nM - fm) : WGM;
        u.pm = fm + ((wgid % nig) % gsz); u.pn = (wgid % nig) / gsz; u.b = Bt + (size_t)u.pn * BM * K * 2; u.e = 0; u.pos0 = 0; u.cnt = 0; u.pad = i; return true;
    }
    __device__ __forceinline__ int a_row(const Unit& u, int r) const { return u.pm * BM + r; }
};
struct MoeOrder {
    const char* W; const int* list; size_t wstride; int nN, K, G, c, gather; int cnt[NE];
    __device__ void init(const unsigned char* ws, const bf16_t* W_, size_t wstride_bytes, int nN_, int K_, int G_, int c_, int gather_) {
        W = (const char*)W_; wstride = wstride_bytes; nN = nN_; K = K_; G = G_; c = c_; gather = gather_; list = (const int*)(ws + WS_LIST);
        const unsigned* cw = (const unsigned*)(ws + WS_CTL) + CW_MOECNT;
#pragma unroll
        for (int e = 0; e < NE; ++e) cnt[e] = __builtin_amdgcn_readfirstlane((int)__hip_atomic_load(cw + e, __ATOMIC_RELAXED, __HIP_MEMORY_SCOPE_AGENT));
    }
    __device__ bool next(int i, Unit& u) const {
        int PT = 0;
#pragma unroll
        for (int e = 0; e < NE; ++e) PT += (cnt[e] + 255) >> 8;
        const int nwg = PT * nN; const long L = (long)i * G + c; if (L >= nwg) return false;
        int wgid = (int)L; { const int q = nwg / NXCD, r = nwg % NXCD, xcd = wgid % NXCD, off = wgid / NXCD; wgid = (xcd < r ? xcd * (q + 1) : r * (q + 1) + (xcd - r) * q) + off; }
        const int nig = WGM * nN, gid = wgid / nig, fm = gid * WGM, gsz = (PT - fm) < WGM ? (PT - fm) : WGM;
        const int pp = fm + ((wgid % nig) % gsz), pn = (wgid % nig) / gsz;
        int pb = 0, found = 0; u.e = 0; u.pos0 = 0; u.cnt = 0; u.pm = 0;
#pragma unroll
        for (int e = 0; e < NE; ++e) { const int np = (cnt[e] + 255) >> 8; if (!found && pp < pb + np) { found = 1; u.e = e; u.pos0 = (pp - pb) * 256; u.cnt = cnt[e]; u.pm = pp; } pb += np; }
        if (!found) return false;
        u.pn = pn; u.pad = i; u.b = W + (size_t)u.e * wstride + (size_t)pn * BM * K * 2; return true;
    }
    __device__ __forceinline__ int a_row(const Unit& u, int r) const {
        if (!gather) return u.pm * BM + r;
        const int pos = u.pos0 + r; const int t_ = list[(size_t)u.e * M + (pos < u.cnt ? pos : 0)] >> 1; return pos < u.cnt ? t_ : 0;
    }
};

template <bool SKIP_EPI = false, bool MID = false, bool F8 = false, class Epi, class Sched>
__device__ __forceinline__ void gemm_phase(LAS unsigned char* lds, const char* A, const int lda, const int K, const Sched& S, const Epi& E, const int tid, const int ksplit = 2, const size_t ajump = 0) {
    const int wid = __builtin_amdgcn_readfirstlane(tid >> 6), lane = tid & 63, wr = wid >> 2, wc = wid & 3, fr = lane & 15, fq = lane >> 4;
    const int nt = K / BK;
    int Rl[2], Cl[2]; unsigned voffB[2];
#pragma unroll
    for (int i = 0; i < 2; ++i) { int R, C; stage_rc(tid * 16 + i * 8192, R, C); Rl[i] = R; Cl[i] = C; const int Rb = (R & ~31) + perm32(R & 31); voffB[i] = (unsigned)(Rb * K + C) * 2u; }
    const size_t kstep = (size_t)(BK * 2);
    const size_t hstepB = (size_t)HALF * K * 2;
    const unsigned ldsw = (unsigned)wid * 1024u;
    const int aoff = lds_byte(wr * 64 + fr, fq * 8), boff = lds_byte(wc * 32 + fr, fq * 8), aoff1 = lds_byte(wr * 64 + fr, fq * 8 + 32) - aoff, boff1 = lds_byte(wc * 32 + fr, fq * 8 + 32) - boff;
#define PG8_SA(b, h) (((b) * 2 + (h)) * HTB)
#define PG8_SB(b, h) ((4 + (b) * 2 + (h)) * HTB)
#define PG8_STAGE(bufoff, gbase, voff) do { __builtin_amdgcn_s_setprio(3); _Pragma("unroll") for (int _i = 0; _i < 2; ++_i) \
        __builtin_amdgcn_global_load_lds((const unsigned*)((const char*)(gbase) + (voff)[_i]), (LAS unsigned*)(lds + (bufoff) + ldsw + _i * 8192), 16, 0, 0); __builtin_amdgcn_s_setprio(0); } while (0)
#define PG8_LDA(dst, b, h) do { _Pragma("unroll") for (int m = 0; m < 4; ++m) { \
        if constexpr (F8) { const v4i_ lo_ = *(const LAS v4i_*)(lds + PG8_SA(b, h) + aoff + m * 2048), hi_ = *(const LAS v4i_*)(lds + PG8_SA(b, h) + aoff + m * 2048 + aoff1); \
            dst[m][0] = __builtin_shufflevector(lo_, hi_, 0, 1, 2, 3, 4, 5, 6, 7); } \
        else { _Pragma("unroll") for (int k = 0; k < 2; ++k) dst[m][k] = *(const LAS bf16x8*)(lds + PG8_SA(b, h) + aoff + m * 2048 + k * aoff1); } } } while (0)
#define PG8_LDB(dst, b, h) do { _Pragma("unroll") for (int n = 0; n < 2; ++n) { \
        if constexpr (F8) { const v4i_ lo_ = *(const LAS v4i_*)(lds + PG8_SB(b, h) + boff + n * 2048), hi_ = *(const LAS v4i_*)(lds + PG8_SB(b, h) + boff + n * 2048 + boff1); \
            dst[n][0] = __builtin_shufflevector(lo_, hi_, 0, 1, 2, 3, 4, 5, 6, 7); } \
        else { _Pragma("unroll") for (int k = 0; k < 2; ++k) dst[n][k] = *(const LAS bf16x8*)(lds + PG8_SB(b, h) + boff + n * 2048 + k * boff1); } } } while (0)
#define PG8_MMA(ai, bj, At, Bt) do { __builtin_amdgcn_s_setprio(2); \
        if constexpr (F8) { _Pragma("unroll") for (int m = 0; m < 4; ++m) _Pragma("unroll") for (int n = 0; n < 2; ++n) \
            asm volatile("v_mfma_scale_f32_16x16x128_f8f6f4 %0, %1, %2, %0, %3, %3 op_sel_hi:[0,0,0]" : "+v"(acc[ai][bj][m][n]) : "v"(Bt[n][0]), "v"(At[m][0]), "v"(sc127)); }         \
        else { _Pragma("unroll") for (int m = 0; m < 4; ++m) _Pragma("unroll") for (int n = 0; n < 2; ++n) _Pragma("unroll") for (int k = 0; k < 2; ++k) \
            acc[ai][bj][m][n] = __builtin_amdgcn_mfma_f32_16x16x32_bf16(Bt[n][k], At[m][k], acc[ai][bj][m][n], 0, 0, 0); } \
        __builtin_amdgcn_s_setprio(0); } while (0)
#define PG8_WAIT_V(n) asm volatile("s_waitcnt vmcnt(" #n ")" ::: "memory")
#define PG8_WAIT_L(n) asm volatile("s_waitcnt lgkmcnt(" #n ")" ::: "memory")
#define PG8_BAR __builtin_amdgcn_s_barrier()
#define PG8_SCHED __builtin_amdgcn_sched_barrier(0)
#define PG8_UOFF(u, off) do { _Pragma("unroll") for (int _h = 0; _h < 2; ++_h) _Pragma("unroll") for (int _i = 0; _i < 2; ++_i) \
        off[_h][_i] = (unsigned)(S.a_row(u, _h * HALF + Rl[_i]) * lda + Cl[_i]) * 2u; } while (0)
    Unit cur, nxt; int ui = 0;
    if (!S.next(0, cur)) return;
    unsigned coff[2][2], noff[2][2];
    PG8_UOFF(cur, coff);
    f32x4 acc[2][2][4][2];
#pragma unroll
    for (int a = 0; a < 2; ++a)
#pragma unroll
        for (int b = 0; b < 2; ++b)
#pragma unroll
            for (int m = 0; m < 4; ++m)
#pragma unroll
                for (int n = 0; n < 2; ++n) acc[a][b][m][n] = (f32x4){0.f, 0.f, 0.f, 0.f};
    typedef int v4i_ __attribute__((ext_vector_type(4))); typedef int v8i_ __attribute__((ext_vector_type(8)));
    int sc127 = 127; asm volatile("" : "+v"(sc127));
    typename std::conditional<F8, v8i_, bf16x8>::type At[4][F8 ? 1 : 2], B0[2][F8 ? 1 : 2], B1[2][F8 ? 1 : 2];
    const char* cB = cur.b;
    PG8_STAGE(PG8_SB(0, 0), cB, voffB); PG8_STAGE(PG8_SB(0, 1), cB + hstepB, voffB); PG8_STAGE(PG8_SA(0, 0), A, coff[0]); PG8_STAGE(PG8_SA(0, 1), A, coff[1]);
    if (wr == 1) PG8_BAR;
    PG8_WAIT_V(2); PG8_BAR;
    PG8_STAGE(PG8_SB(1, 0), cB + kstep, voffB); PG8_STAGE(PG8_SA(1, 0), A + kstep, coff[0]); PG8_STAGE(PG8_SB(1, 1), cB + hstepB + kstep, voffB);
    PG8_WAIT_V(6); PG8_BAR;
    for (;;) {
        const bool has_next = S.next(ui + 1, nxt);
        if (has_next) { PG8_UOFF(nxt, noff); } else {
#pragma unroll
            for (int h = 0; h < 2; ++h)
#pragma unroll
                for (int i = 0; i < 2; ++i) noff[h][i] = coff[h][i]; }
        const char* nB = has_next ? nxt.b : cB;
        for (int t = 0; t < nt; t += 2) {
            const bool last = (t == nt - 2);
#define PG8_AK(kt) (A + (size_t)(kt) * kstep + ((kt) >= ksplit ? ajump : (size_t)0))
            const char* a1 = PG8_AK(t + 1);
            const char* a2 = last ? A : PG8_AK(t + 2); const char* b2 = last ? nB : cB + (size_t)(t + 2) * kstep;
            const char* a3 = last ? A + kstep : PG8_AK(t + 3); const char* b3 = b2 + kstep;
            unsigned o2[2][2];
#pragma unroll
            for (int h = 0; h < 2; ++h)
#pragma unroll
                for (int i = 0; i < 2; ++i) o2[h][i] = last ? noff[h][i] : coff[h][i];
            PG8_LDB(B0, 0, 0); PG8_LDB(B1, 0, 1); PG8_SCHED; PG8_LDA(At, 0, 0); PG8_STAGE(PG8_SA(1, 1), a1, coff[1]);
            PG8_WAIT_V(8); PG8_WAIT_L(0); PG8_BAR; PG8_MMA(0, 0, At, B0); PG8_MMA(0, 1, At, B1); PG8_BAR; PG8_SCHED;
            PG8_LDA(At, 0, 1); PG8_STAGE(PG8_SB(0, 0), b2, voffB); PG8_STAGE(PG8_SB(0, 1), b2 + hstepB, voffB); PG8_STAGE(PG8_SA(0, 0), a2, o2[0]);
            PG8_WAIT_V(8); PG8_WAIT_L(0); PG8_BAR; PG8_MMA(1, 0, At, B0); PG8_MMA(1, 1, At, B1); PG8_BAR; PG8_SCHED;
            PG8_LDB(B0, 1, 0); PG8_LDB(B1, 1, 1); PG8_SCHED; PG8_LDA(At, 1, 0); PG8_STAGE(PG8_SA(0, 1), a2, o2[1]);
            PG8_WAIT_V(8); PG8_WAIT_L(0); PG8_BAR; PG8_MMA(0, 0, At, B0); PG8_MMA(0, 1, At, B1); PG8_BAR; PG8_SCHED;
            PG8_LDA(At, 1, 1); PG8_STAGE(PG8_SB(1, 0), b3, voffB); PG8_STAGE(PG8_SB(1, 1), b3 + hstepB, voffB); PG8_STAGE(PG8_SA(1, 0), a3, o2[0]);
            PG8_WAIT_V(8); PG8_WAIT_L(0); PG8_BAR; PG8_MMA(1, 0, At, B0); PG8_MMA(1, 1, At, B1); PG8_BAR; PG8_SCHED;
            if constexpr (MID) { if (t + 2 == ksplit) E.mid(acc, cur, wr, wc, fr, fq); }
        }
        if constexpr (F8) asm volatile("s_nop 15\n\ts_nop 15" ::: "memory");
        if (PG8_ALIGN_EPI) { if (wr == 0) PG8_BAR; }
        if (!SKIP_EPI) E(acc, cur, wr, wc, fr, fq); else { _Pragma("unroll") for (int a_ = 0; a_ < 2; ++a_) _Pragma("unroll") for (int b_ = 0; b_ < 2; ++b_) _Pragma("unroll") for (int m_ = 0; m_ < 4; ++m_) asm volatile("" :: "v"(acc[a_][b_][m_][0]), "v"(acc[a_][b_][m_][1])); }
        if (!has_next) break;
        cur = nxt; cB = nB; ++ui;
#pragma unroll
        for (int h = 0; h < 2; ++h)
#pragma unroll
            for (int i = 0; i < 2; ++i) coff[h][i] = noff[h][i];
        if (PG8_ALIGN_EPI) { if (wr == 1) PG8_BAR; }
    }
    PG8_WAIT_V(0);
    if (!PG8_ALIGN_EPI) { if (wr == 0) PG8_BAR; }
    PG8_BAR;
#undef PG8_SA
#undef PG8_SB
#undef PG8_STAGE
#undef PG8_LDA
#undef PG8_LDB
#undef PG8_MMA
#undef PG8_WAIT_V
#undef PG8_WAIT_L
#undef PG8_BAR
#undef PG8_SCHED
#undef PG8_UOFF
#undef PG8_AK
}

typedef f32x4 Acc[2][2][4][2];
#define PG8_ZERO_ROW(ai_, m_) do { acc[ai_][0][m_][0] = (f32x4){0.f, 0.f, 0.f, 0.f}; acc[ai_][0][m_][1] = (f32x4){0.f, 0.f, 0.f, 0.f}; acc[ai_][1][m_][0] = (f32x4){0.f, 0.f, 0.f, 0.f}; acc[ai_][1][m_][1] = (f32x4){0.f, 0.f, 0.f, 0.f}; } while (0)
constexpr int RSL_OFF = 132096, RSL_UNITS = 13;
template <class Sched> __device__ __forceinline__ void fill_rstd(LAS unsigned char* lds, const float* ssq, const Sched& S, int tid) {
    LAS float* tab = (LAS float*)(lds + RSL_OFF); const int lane = tid & 63, wid = __builtin_amdgcn_readfirstlane(tid >> 6); Unit u;
    for (int i = wid; i < RSL_UNITS && S.next(i, u); i += 8) {
        f32x4 p[16];
#pragma unroll
        for (int k = 0; k < 16; ++k) p[k] = *(const f32x4*)(ssq + (size_t)(u.pm * BM + (lane >> 2) + 16 * k) * 16 + 4 * (lane & 3));
#pragma unroll
        for (int k = 0; k < 16; ++k) { float s_ = (p[k].x + p[k].y) + (p[k].z + p[k].w); s_ = sum_quad(s_);
            if ((lane & 3) == 0) tab[i * 256 + (lane >> 2) + 16 * k] = __builtin_amdgcn_rsqf(s_ * (1.0f / DM) + EPS); }
    }
    asm volatile("s_waitcnt vmcnt(0) lgkmcnt(0)\n\ts_barrier" ::: "memory");
}
__device__ __forceinline__ void fill_rstd_moe(LAS unsigned char* lds, const float* rpos, const MoeOrder& S, int tid) {
    LAS float* tab = (LAS float*)(lds + RSL_OFF); const int lane = tid & 63, wid = __builtin_amdgcn_readfirstlane(tid >> 6); Unit u;
    for (int i = wid; i < RSL_UNITS && S.next(i, u); i += 8) {
#pragma unroll
        for (int k = 0; k < 4; ++k) { const int pos = u.pos0 + lane + 64 * k; tab[i * 256 + lane + 64 * k] = pos < u.cnt ? rpos[(size_t)u.e * M + pos] : 0.f; }
    }
    asm volatile("s_waitcnt vmcnt(0) lgkmcnt(0)\n\ts_barrier" ::: "memory");
}
__device__ __forceinline__ void rows_rstd(LAS const float* rsl, const Unit& u, int wr, int fr, float (&rs)[2][4]) {
#pragma unroll
    for (int ai = 0; ai < 2; ++ai)
#pragma unroll
        for (int m = 0; m < 4; ++m) rs[ai][m] = rsl[u.pad * 256 + wr * 64 + fr + ai * HALF + m * 16];
}
__device__ __forceinline__ v4u pack8(const f32x4 a, const f32x4 b) { v4u w; w.x = cvt_pk_bf16(a[0], a[1]); w.y = cvt_pk_bf16(a[2], a[3]); w.z = cvt_pk_bf16(b[0], b[1]); w.w = cvt_pk_bf16(b[2], b[3]); return w; }

__device__ __forceinline__ v4u lane_t4(v4u x, int lane) {
    const int src = (((lane & 3) << 4) | (lane >> 2)) << 2; v4u r;
#pragma unroll
    for (int k = 0; k < 4; ++k) r[k] = (unsigned)__builtin_amdgcn_ds_bpermute(src, (int)x[k]);
    return r;
}
struct EpiIn {
    bf16_t* qkv; LAS const float* rsl; const float* g_q; const float* g_k;
    __device__ __forceinline__ void operator()(Acc& acc, const Unit& u, int wr, int wc, int fr, int fq) const {
        const int row0 = u.pm * BM + wr * 64 + fr, j = u.pn;
        float rs[2][4]; rows_rstd(rsl, u, wr, fr, rs);
        {
            const int which = j >> 1; const bool nrm = (which == 3 || which == 4);
            f32x4 gv[2][2];
#pragma unroll
            for (int bj = 0; bj < 2; ++bj)
#pragma unroll
                for (int n = 0; n < 2; ++n) gv[bj][n] = nrm ? *(const f32x4*)((which == 3 ? g_q : g_k) + 32 * bj + 8 * fq + 4 * n) : (f32x4){1.f, 1.f, 1.f, 1.f};
            const float cs = (which == 0 || which == 3) ? C2 : 1.0f;
            const int ln_ = fq * 16 + fr;
            bf16_t* base = qkv + (size_t)(u.pm * BM + wr * 64 + (ln_ >> 2)) * QP + j * 256 + wc * 64 + 8 * (ln_ & 3);
#pragma unroll
            for (int ai = 0; ai < 2; ++ai)
#pragma unroll
                for (int m = 0; m < 4; ++m) {
                    f32x4 v[2][2]; float ss = 0.f;
#pragma unroll
                    for (int bj = 0; bj < 2; ++bj)
#pragma unroll
                        for (int n = 0; n < 2; ++n) { v[bj][n] = acc[ai][bj][m][n] * rs[ai][m]; const f32x4 q = v[bj][n] * v[bj][n]; ss += (q[0] + q[1]) + (q[2] + q[3]); }
                    PG8_ZERO_ROW(ai, m);
                    float sc = cs;
                    if (nrm) { ss = sum_x32(sum_x16(ss)); sc *= __builtin_amdgcn_rsqf(ss * (1.0f / HD) + EPS); }
                    bf16_t* rowp = base + (size_t)(ai * HALF + m * 16) * QP;
#pragma unroll
                    for (int bj = 0; bj < 2; ++bj) *(v4u*)(rowp + 32 * bj) = lane_t4(pack8(v[bj][0] * sc * gv[bj][0], v[bj][1] * sc * gv[bj][1]), ln_);
                }
        }
    }
};
struct EpiGate {
    bf16_t* gates; LAS const float* rsl; const float* b_gate;
    __device__ __forceinline__ void operator()(Acc& acc, const Unit& u, int wr, int wc, int fr, int fq) const {
        const int row0 = u.pm * BM + wr * 64 + fr;
        float rs[2][4]; rows_rstd(rsl, u, wr, fr, rs);
        const int cg = u.pn * 128 + wc * 32 + 8 * fq;
        f32x4 bs[2], bx[2];
#pragma unroll
        for (int n = 0; n < 2; ++n) { bs[n] = *(const f32x4*)(b_gate + cg + 4 * n); bx[n] = *(const f32x4*)(b_gate + DM + cg + 4 * n); }
        unsigned char* base = (unsigned char*)gates + (size_t)row0 * NGATE + cg * 2;
#pragma unroll
        for (int ai = 0; ai < 2; ++ai)
#pragma unroll
            for (int m = 0; m < 4; ++m) { unsigned char* rowp = base + (size_t)(ai * HALF + m * 16) * NGATE; unsigned qs[2] = {0u, 0u}, qx[2] = {0u, 0u}; const float sc = rs[ai][m] * GATE_INV;
#pragma unroll
                for (int n = 0; n < 2; ++n) { const f32x4 xa = acc[ai][0][m][n] * sc + bs[n], xb_ = acc[ai][1][m][n] * sc + bx[n];
#pragma unroll
                    for (int i = 0; i < 4; ++i) { const float ea = __builtin_amdgcn_exp2f(-LOG2E * xa[i]), eb = __builtin_amdgcn_exp2f(-LOG2E * xb_[i]);
                        qs[n] = __builtin_amdgcn_cvt_pk_u8_f32(__builtin_rintf(255.0f * __builtin_amdgcn_rcpf(1.0f + ea)), i, qs[n]);
                        qx[n] = __builtin_amdgcn_cvt_pk_u8_f32(fmaxf(__builtin_rintf(255.0f * __builtin_amdgcn_rcpf(1.0f + eb)), 1.0f), i, qx[n]); } }
                v4u w; w.x = qs[0]; w.y = qs[1]; w.z = qx[0]; w.w = qx[1]; *(v4u*)rowp = w; PG8_ZERO_ROW(ai, m); }
    }
};
struct EpiOM {
    bf16_t* qkv; const bf16_t* gates;
#define PG8_UB(w, i) ((float)(((w) >> (8 * (i))) & 0xffu))
    __device__ __forceinline__ void mid(Acc& acc, const Unit& u, int wr, int wc, int fr, int fq) const {
        int row0 = u.pm * BM + wr * 64 + fr; const int col0 = u.pn * BM + wc * 32 + 8 * fq;
        asm volatile("" : "+v"(row0));
#pragma unroll
        for (int ai = 0; ai < 2; ++ai) {
            v4u g[4][2];
#pragma unroll
            for (int m = 0; m < 4; ++m)
#pragma unroll
                for (int bj = 0; bj < 2; ++bj) g[m][bj] = *(const v4u*)((const unsigned char*)gates + (size_t)(row0 + ai * HALF + m * 16) * NGATE + (col0 + bj * HALF) * 2);
#pragma unroll
            for (int m = 0; m < 4; ++m)
#pragma unroll
                for (int bj = 0; bj < 2; ++bj) { const v4u gg = g[m][bj]; f32x4& a = acc[ai][bj][m][0]; f32x4& b = acc[ai][bj][m][1];
#pragma unroll
                    for (int i = 0; i < 4; ++i) { a[i] *= PG8_UB(gg.x, i) * __builtin_amdgcn_rcpf(PG8_UB(gg.z, i)); b[i] *= PG8_UB(gg.y, i) * __builtin_amdgcn_rcpf(PG8_UB(gg.w, i)); } }
            asm volatile("" ::: "memory"); }
    }
    __device__ __forceinline__ void operator()(Acc& acc, const Unit& u, int wr, int wc, int fr, int fq) const {
        const int row0 = u.pm * BM + wr * 64 + fr, col0 = u.pn * BM + wc * 32 + 8 * fq;
        v2u g[2][4][2];
#pragma unroll
        for (int ai = 0; ai < 2; ++ai)
#pragma unroll
            for (int m = 0; m < 4; ++m)
#pragma unroll
                for (int bj = 0; bj < 2; ++bj) g[ai][m][bj] = *(const v2u*)((const unsigned char*)gates + (size_t)(row0 + ai * HALF + m * 16) * NGATE + (col0 + bj * HALF) * 2 + 8);
#pragma unroll
        for (int ai = 0; ai < 2; ++ai)
#pragma unroll
            for (int m = 0; m < 4; ++m) { const size_t row = (size_t)(row0 + ai * HALF + m * 16);
#pragma unroll
                for (int bj = 0; bj < 2; ++bj) { const v2u gg = g[ai][m][bj];
                    f32x4 a = acc[ai][bj][m][0], b = acc[ai][bj][m][1];
#pragma unroll
                    for (int i = 0; i < 4; ++i) { a[i] *= PG8_UB(gg.x, i) * (1.0f / 255.0f); b[i] *= PG8_UB(gg.y, i) * (1.0f / 255.0f); }
                    *(v4u*)(qkv + row * QP + 512 + col0 + bj * HALF) = pack8(a, b); } PG8_ZERO_ROW(ai, m); }
    }
#undef PG8_UB
};
template <bool RES_F32, bool X8 = false> struct EpiResT {
    const void* res; bf16_t* xb; float* ssq; unsigned char* xb8; float oscale;
    __device__ __forceinline__ void operator()(Acc& acc, const Unit& u, int wr, int wc, int fr, int fq) const {
        const int row0 = u.pm * BM + wr * 64 + fr, col0 = u.pn * BM + wc * 64 + 8 * fq;
#pragma unroll
        for (int ai = 0; ai < 2; ++ai) {
            f32x4 ra[4][2], rb[4][2];
#pragma unroll
            for (int m = 0; m < 4; ++m)
#pragma unroll
                for (int bj = 0; bj < 2; ++bj) { const size_t o = (size_t)(row0 + ai * HALF + m * 16) * DM + col0 + bj * 32;
                    if (RES_F32) { ra[m][bj] = *(const f32x4*)((const float*)res + o); rb[m][bj] = *(const f32x4*)((const float*)res + o + 4); }
                    else { const v4u t = *(const v4u*)((const bf16_t*)res + o); ra[m][bj] = __builtin_bit_cast(f32x4, (v4u){t.x << 16, t.x & 0xffff0000u, t.y << 16, t.y & 0xffff0000u}); rb[m][bj] = __builtin_bit_cast(f32x4, (v4u){t.z << 16, t.z & 0xffff0000u, t.w << 16, t.w & 0xffff0000u}); } }
            asm volatile("" ::: "memory");
#pragma unroll
            for (int m = 0; m < 4; ++m) { const size_t row = (size_t)(row0 + ai * HALF + m * 16); float ss = 0.f;
#pragma unroll
                for (int bj = 0; bj < 2; ++bj) { const size_t o = row * DM + col0 + bj * 32;
                    const f32x4 a = ra[m][bj] + acc[ai][bj][m][0] * oscale, b = rb[m][bj] + acc[ai][bj][m][1] * oscale;
                    *(v4u*)(xb + o) = pack8(a, b);
                    if (X8) { int lo_ = 0, hi_ = 0; lo_ = __builtin_amdgcn_cvt_pk_fp8_f32(a[0] * X8_SCALE, a[1] * X8_SCALE, lo_, false); lo_ = __builtin_amdgcn_cvt_pk_fp8_f32(a[2] * X8_SCALE, a[3] * X8_SCALE, lo_, true);
                        hi_ = __builtin_amdgcn_cvt_pk_fp8_f32(b[0] * X8_SCALE, b[1] * X8_SCALE, hi_, false); hi_ = __builtin_amdgcn_cvt_pk_fp8_f32(b[2] * X8_SCALE, b[3] * X8_SCALE, hi_, true);
                        *(unsigned long long*)(xb8 + o) = (unsigned long long)(unsigned)lo_ | ((unsigned long long)(unsigned)hi_ << 32); }
                    const f32x4 qa = a * a, qb = b * b; ss += ((qa[0] + qa[1]) + (qa[2] + qa[3])) + ((qb[0] + qb[1]) + (qb[2] + qb[3])); }
                ss = sum_x32(sum_x16(ss));
                if (fq == 0) ssq[row * 16 + u.pn * 4 + wc] = ss; PG8_ZERO_ROW(ai, m); }
        }
    }
};
__device__ __forceinline__ unsigned long long swiglu8_f8(const f32x4 g0, const f32x4 g1, const f32x4 u0, const f32x4 u1, float r) {
    f32x4 a, b; const float r1 = -LOG2E * r, r2 = r * r * ACT_SCALE;
#pragma unroll
    for (int i = 0; i < 4; ++i) { a[i] = (g0[i] * u0[i]) * __builtin_amdgcn_rcpf(1.0f + __builtin_amdgcn_exp2f(g0[i] * r1)) * r2; b[i] = (g1[i] * u1[i]) * __builtin_amdgcn_rcpf(1.0f + __builtin_amdgcn_exp2f(g1[i] * r1)) * r2; }
    int lo = 0, hi = 0; lo = __builtin_amdgcn_cvt_pk_fp8_f32(a[0], a[1], lo, false); lo = __builtin_amdgcn_cvt_pk_fp8_f32(a[2], a[3], lo, true);
    hi = __builtin_amdgcn_cvt_pk_fp8_f32(b[0], b[1], hi, false); hi = __builtin_amdgcn_cvt_pk_fp8_f32(b[2], b[3], hi, true);
    return (unsigned long long)(unsigned)lo | ((unsigned long long)(unsigned)hi << 32);
}
struct EpiUp {
    unsigned char* act; LAS const float* rsl;
    __device__ __forceinline__ void operator()(Acc& acc, const Unit& u, int wr, int wc, int fr, int fq) const {
        const int row0 = u.pm * BM + wr * 64 + fr;
        float rs[2][4]; rows_rstd(rsl, u, wr, fr, rs);
        unsigned char* base = act + (size_t)row0 * DFF + u.pn * 128 + wc * 32 + 8 * fq;
#pragma unroll
        for (int ai = 0; ai < 2; ++ai)
#pragma unroll
            for (int m = 0; m < 4; ++m) { *(unsigned long long*)(base + (size_t)(ai * HALF + m * 16) * DFF) = swiglu8_f8(acc[ai][0][m][0], acc[ai][0][m][1], acc[ai][1][m][0], acc[ai][1][m][1], rs[ai][m]); PG8_ZERO_ROW(ai, m); }
    }
};
struct EpiMoeUp {
    unsigned char* act; LAS const float* rsl;
    __device__ __forceinline__ void operator()(Acc& acc, const Unit& u, int wr, int wc, int fr, int fq) const {
        const int r0 = wr * 64 + fr;
        unsigned char* base = act + (size_t)(u.pm * BM + r0) * DFE8 + u.pn * 128 + wc * 32 + 8 * fq;
#pragma unroll
        for (int ai = 0; ai < 2; ++ai)
#pragma unroll
            for (int m = 0; m < 4; ++m) { const float r = rsl[u.pad * 256 + r0 + ai * HALF + m * 16];
                unsigned char* rp = base + (size_t)(ai * HALF + m * 16) * DFE8;
                *(unsigned long long*)rp = swiglu8_f8(acc[ai][0][m][0], acc[ai][0][m][1], acc[ai][1][m][0], acc[ai][1][m][1], r);
                if (u.pn == DFE / 128 - 1) *(unsigned long long*)(rp + 128) = 0ull; PG8_ZERO_ROW(ai, m); }
    }
};
struct EpiMoeDn {
    bf16_t* y; const float* tok_w; const int* list;
    __device__ __forceinline__ void operator()(Acc& acc, const Unit& u, int wr, int wc, int fr, int fq) const {
        const int r0 = wr * 64 + fr, col0 = u.pn * BM + wc * 32 + 8 * fq;
        int ent[2][4]; float w[2][4];
#pragma unroll
        for (int ai = 0; ai < 2; ++ai)
#pragma unroll
            for (int m = 0; m < 4; ++m) { const int pos = u.pos0 + r0 + ai * HALF + m * 16; const size_t o_ = (size_t)u.e * M + (pos < u.cnt ? pos : 0);
                ent[ai][m] = list[o_]; w[ai][m] = tok_w[o_]; }
        asm volatile("" ::: "memory");
#pragma unroll
        for (int ai = 0; ai < 2; ++ai)
#pragma unroll
            for (int m = 0; m < 4; ++m) { const int pos = u.pos0 + r0 + ai * HALF + m * 16; if (pos >= u.cnt) ent[ai][m] = -1; w[ai][m] *= DN_INV; }
#pragma unroll
        for (int ai = 0; ai < 2; ++ai)
#pragma unroll
            for (int m = 0; m < 4; ++m) {
                if (ent[ai][m] >= 0) { bf16_t* yp = y + (size_t)ent[ai][m] * DM + col0;
#pragma unroll
                    for (int bj = 0; bj < 2; ++bj) *(v4u*)(yp + bj * HALF) = pack8(acc[ai][bj][m][0] * w[ai][m], acc[ai][bj][m][1] * w[ai][m]); } PG8_ZERO_ROW(ai, m); }
    }
};
}
namespace attn {
constexpr int NW = 8, QBLK = 32, QB = 256, KVBLK = 64;
constexpr int NS = 7, SLOTB = 8192, LDS_K = 0, LDS_V = NS * SLOTB, LDS_FB = 2 * NS * SLOTB, LDS_OST = 0  , LDS_WS = 132096  ,
              LDS_SCAN = LDS_WS + NW * 256, LDS_FLAG = LDS_SCAN + 64, LDS_BYTES = LDS_FLAG + 64;
static_assert(LDS_FB + SEQ * 4 <= 131072 && NW * 4096 <= NS * SLOTB, "attention LDS map");
typedef LAS const char* lds_cptr;
typedef short v4i16_t __attribute__((ext_vector_type(4)));
#define ATT_SBAR() __builtin_amdgcn_sched_barrier(0)
#define ATT_WAIT_BAR(N) asm volatile("s_waitcnt vmcnt(" #N ") lgkmcnt(0)\n\ts_barrier" ::: "memory")
#define ATT_MFMA(a, b, c) __builtin_amdgcn_mfma_f32_32x32x16_bf16(a, b, c, 0, 0, 0)
__device__ __forceinline__ int crow(int r, int hi) { return (r & 3) + 8 * (r >> 2) + 4 * hi; }
__device__ __forceinline__ void glds16(const void* g, unsigned lds_base) {
    unsigned sv; asm volatile("s_mov_b32 %0, m0\n\ts_mov_b32 m0, %2\n\ts_nop 0\n\tglobal_load_lds_dwordx4 %1, off\n\ts_mov_b32 m0, %0" : "=&s"(sv) : "v"(g), "s"(lds_base) : "memory"); }
__device__ __forceinline__ void kload8(bf16x8* kf, lds_cptr kpa, lds_cptr kpb) {
    kf[0] = *(const LAS bf16x8*)(kpa); kf[1] = *(const LAS bf16x8*)(kpa + 2048); kf[2] = *(const LAS bf16x8*)(kpb); kf[3] = *(const LAS bf16x8*)(kpb + 2048);
    kf[4] = *(const LAS bf16x8*)(kpa + 4096); kf[5] = *(const LAS bf16x8*)(kpa + 6144); kf[6] = *(const LAS bf16x8*)(kpb + 4096); kf[7] = *(const LAS bf16x8*)(kpb + 6144);
}
__device__ __forceinline__ void pv(f32x16* o, int vb, bf16x8 pa0, bf16x8 pa1, bf16x8 pa2, bf16x8 pa3) {
#pragma unroll
    for (int d0 = 0; d0 < 2; ++d0) { s16x4 lo[4], hi[4];
#pragma unroll
        for (int ks = 0; ks < 4; ++ks) {
            asm volatile("ds_read_b64_tr_b16 %0,%1 offset:%c2" : "=&v"(lo[ks]) : "v"(vb), "i"(d0 * 4096 + ks * 1024) : "memory");
            asm volatile("ds_read_b64_tr_b16 %0,%1 offset:%c2" : "=&v"(hi[ks]) : "v"(vb), "i"(d0 * 4096 + ks * 1024 + 512) : "memory"); }
        asm volatile("s_waitcnt lgkmcnt(0)" ::: "memory"); ATT_SBAR();
#define ATT_PK(k) (bf16x8){lo[k][0], lo[k][1], lo[k][2], lo[k][3], hi[k][0], hi[k][1], hi[k][2], hi[k][3]}
        o[d0] = ATT_MFMA(pa0, ATT_PK(0), o[d0]); o[d0] = ATT_MFMA(pa1, ATT_PK(1), o[d0]); o[d0] = ATT_MFMA(pa2, ATT_PK(2), o[d0]); o[d0] = ATT_MFMA(pa3, ATT_PK(3), o[d0]);
#undef ATT_PK
    }
}
__device__ __forceinline__ float swap_max(float m) { auto rr = __builtin_amdgcn_permlane32_swap(__float_as_uint(m), __float_as_uint(m), false, false); return fmaxf(__uint_as_float(rr[0]), __uint_as_float(rr[1])); }

template <int FOX>
__device__ __forceinline__ void attn_unit(const int b, const int h, const int qb, bf16_t* qkv, const float* logf, LAS char* shm, const int tid, const float qkb, const bool dostore) {
    const int lane = tid & 63, r32 = lane & 31, hi = lane >> 5; const int wid = __builtin_amdgcn_readfirstlane(tid >> 6);
    const size_t rowbase = (size_t)b * SEQ; const int q0 = qb * QB, NT = (q0 + QB) / KVBLK;
    const int qc = FOX ? 1536 : 0;
    const bf16_t* Qw = qkv + (rowbase + q0 + wid * QBLK) * QP + qc + h * HD;
    const bf16_t* Kh = qkv + rowbase * QP + qc + 512 + h * HD; const bf16_t* Vh = Kh + 512;
    const unsigned lds0 = (unsigned)(uintptr_t)shm;
    LAS float* wsf = (LAS float*)(shm + LDS_WS) + wid * 64;
    LAS float* Fb = (LAS float*)(shm + LDS_FB);
    LAS unsigned* flags = (LAS unsigned*)(shm + LDS_FLAG);
    const bf16_t* ksrc = Kh + (size_t)(16 * (wid & 3) + (lane >> 2)) * QP + (wid >> 2) * 32 + ((lane & 3) ^ ((lane >> 4) & 3)) * 8;
    const bf16_t* vsrc = Vh + (size_t)(16 * (wid & 3) + (lane >> 2)) * QP + (wid >> 2) * 32 + (lane & 3) * 8;
    const unsigned kdst = lds0 + LDS_K + wid * 1024, vdst = lds0 + LDS_V + wid * 1024;
#define ATT_DMA_K(t, slot) glds16(ksrc + (size_t)(t) * KVBLK * QP, (unsigned)__builtin_amdgcn_readfirstlane(kdst + (slot)))
#define ATT_DMA_V(t, slot) glds16(vsrc + (size_t)(t) * KVBLK * QP, (unsigned)__builtin_amdgcn_readfirstlane(vdst + (slot)))
    const int vb0 = (int)(lds0 + LDS_V) + ((lane >> 4) & 1) * 32 + (lane & 3) * 8 + (4 * hi + ((lane & 15) >> 2)) * 64;
    const int ksw = (r32 >> 2) & 3, kbase = (r32 >> 4) * 1024 + (r32 & 15) * 64;
    const lds_cptr kpA = (lds_cptr)shm + LDS_K + kbase + ((hi ^ ksw) * 16), kpB = (lds_cptr)shm + LDS_K + kbase + (((2 + hi) ^ ksw) * 16);
    bf16x8 qr[4];
#pragma unroll
    for (int d0 = 0; d0 < 4; ++d0) qr[d0] = *reinterpret_cast<const bf16x8*>(&Qw[(size_t)r32 * QP + d0 * 16 + hi * 8]);
    const int qrel = wid * QBLK + r32;
    const int sh = 3 - (wid >> 1);
    ATT_DMA_K(NT - 1, 0); ATT_DMA_V(NT - 1, 0); ATT_DMA_K(NT - 2, SLOTB); ATT_DMA_V(NT - 2, SLOTB); ATT_DMA_K(NT - 3, 2 * SLOTB); ATT_DMA_V(NT - 3, 2 * SLOTB); ATT_DMA_K(NT - 4, 3 * SLOTB); ATT_DMA_V(NT - 4, 3 * SLOTB);
    if (NT >= 8) { ATT_DMA_K(NT - 5, 4 * SLOTB); ATT_DMA_V(NT - 5, 4 * SLOTB); ATT_DMA_K(NT - 6, 5 * SLOTB); ATT_DMA_V(NT - 6, 5 * SLOTB); }
    if (FOX) {
        const float* lf = logf + (size_t)(b * NH + h) * SEQ; const int L = q0 + QB, i0 = tid * 8;
        float v[8];
        if (i0 < L) { const f32x4 a = *(const f32x4*)(lf + i0), c = *(const f32x4*)(lf + i0 + 4); v[0] = a.x; v[1] = a.y; v[2] = a.z; v[3] = a.w; v[4] = c.x; v[5] = c.y; v[6] = c.z; v[7] = c.w; }
        else {
#pragma unroll
            for (int k = 0; k < 8; ++k) v[k] = 0.f; }
#pragma unroll
        for (int k = 1; k < 8; ++k) v[k] += v[k - 1];
        float x = v[7];
#pragma unroll
        for (int o = 1; o < 64; o <<= 1) { const float y = __shfl_up(x, o); if (lane >= o) x += y; }
        LAS float* wt = (LAS float*)(shm + LDS_SCAN);
        if (lane == 63) wt[wid] = x;
        asm volatile("s_waitcnt lgkmcnt(0)\n\ts_barrier" ::: "memory");
        float off = x - v[7];
#pragma unroll
        for (int w = 0; w < 8; ++w) off += (w < wid) ? wt[w] : 0.f;
        if (i0 < L) {
#pragma unroll
            for (int k = 0; k < 8; ++k) Fb[i0 + k] = off + v[k]; }
        asm volatile("s_waitcnt lgkmcnt(0)\n\ts_barrier" ::: "memory");
        const float Fq0 = Fb[q0];
        asm volatile("s_waitcnt lgkmcnt(0)\n\ts_barrier" ::: "memory");
        if (i0 < L) {
#pragma unroll
            for (int k = 0; k < 8; ++k) Fb[i0 + k] = (Fq0 - (off + v[k])) * LOG2E; }
        asm volatile("s_waitcnt lgkmcnt(0)\n\ts_barrier" ::: "memory");
    }
    f32x16 o[2]; o[0] = f32x16{}; o[1] = f32x16{};
    float carry = 1.0f;
    float mhat = FOX ? Fb[q0 + qrel] + fminf(qkb, 30.0f) : 0.f;
    float l_reg = 0.f;
    f32x16 pA0, pA1, pB0, pB1;
#define ATT_QK(P0, P1, i_) do { const int t_ = NT - 1 - ((i_) + sh); bf16x8 kf[8]; kload8(kf, kpA + (((i_) + sh) % NS) * SLOTB, kpB + (((i_) + sh) % NS) * SLOTB); f32x16 c0, c1; \
        if (FOX) { _Pragma("unroll") for (int jj = 0; jj < 4; ++jj) { const f32x4 a_ = *(const LAS f32x4*)(Fb + t_ * KVBLK + 8 * jj + 4 * hi), c_ = *(const LAS f32x4*)(Fb + t_ * KVBLK + 32 + 8 * jj + 4 * hi); \
            _Pragma("unroll") for (int k = 0; k < 4; ++k) { c0[4 * jj + k] = a_[k]; c1[4 * jj + k] = c_[k]; } } } else { c0 = f32x16{}; c1 = f32x16{}; } \
        P0 = ATT_MFMA(kf[0], qr[0], c0); P1 = ATT_MFMA(kf[1], qr[0], c1); \
        _Pragma("unroll") for (int d0 = 1; d0 < 4; ++d0) { P0 = ATT_MFMA(kf[2 * d0], qr[d0], P0); P1 = ATT_MFMA(kf[2 * d0 + 1], qr[d0], P1); } } while (0)
    if (NT >= 8) { ATT_WAIT_BAR(4); } else { ATT_WAIT_BAR(0); }
    ATT_QK(pA0, pA1, 0);
    bool done = false;
#define ATT_STEP(p0, p1, n0, n1, i, BAND) { \
        if ((i) + 5 < NT) { ATT_WAIT_BAR(2); } else { ATT_WAIT_BAR(0); }        \
        if ((i) >= 1) {     \
            const v4u fa = *(const LAS v4u*)(flags + (((i) - 1) & 1) * 8), fb = *(const LAS v4u*)(flags + (((i) - 1) & 1) * 8 + 4); \
            if (__builtin_amdgcn_readfirstlane((int)((fa.x | fa.y) | (fa.z | fa.w) | (fb.x | fb.y) | (fb.z | fb.w))) == 0) { done = true; break; } } \
        if ((i) + 6 < NT) { ATT_DMA_K(NT - 7 - (i), (((i) + 6) % NS) * SLOTB); ATT_DMA_V(NT - 7 - (i), (((i) + 6) % NS) * SLOTB); } \
        const int Lw = (i) + sh; \
        if (Lw + 1 < NT) ATT_QK(n0, n1, (i) + 1); \
        ATT_SBAR(); \
        const int t = NT - 1 - Lw; const bool band = ((i) == 0); const int jb = wid >> 1; \
        if (Lw < NT) {        \
        if (FOX) { \
            if (band) { asm volatile("; band mask" ::: "memory"); _Pragma("unroll") for (int r = 0; r < 16; ++r) { const int kv = 64 * jb + crow(r, hi); if (kv > qrel) p0[r] = -INFINITY; if (kv + 32 > qrel) p1[r] = -INFINITY; } } \
            float sacc = 0.f; \
            _Pragma("unroll") for (int r = 0; r < 16; ++r) { p0[r] = __builtin_amdgcn_exp2f(p0[r] - mhat); p1[r] = __builtin_amdgcn_exp2f(p1[r] - mhat); sacc += p0[r] + p1[r]; } \
            l_reg += sacc; \
        } else { \
              \
            _Pragma("unroll") for (int r = 0; r < 16; ++r) { \
                p0[r] = __builtin_amdgcn_rcpf(1.0f + __builtin_amdgcn_exp2f(-p0[r])); p1[r] = __builtin_amdgcn_rcpf(1.0f + __builtin_amdgcn_exp2f(-p1[r])); } \
            if (band) { asm volatile("; band mask" ::: "memory"); _Pragma("unroll") for (int r = 0; r < 16; ++r) { const int kv = 64 * jb + crow(r, hi); if (kv >= qrel) p0[r] = 0.f; if (kv + 32 >= qrel) p1[r] = 0.f; } }       \
            float G[8], mix[8], pp[8]; \
            _Pragma("unroll") for (int j = 0; j < 4; ++j) { G[j] = ((1.0f - p0[4 * j]) * (1.0f - p0[4 * j + 1])) * ((1.0f - p0[4 * j + 2]) * (1.0f - p0[4 * j + 3])); \
                G[j + 4] = ((1.0f - p1[4 * j]) * (1.0f - p1[4 * j + 1])) * ((1.0f - p1[4 * j + 2]) * (1.0f - p1[4 * j + 3])); } \
            _Pragma("unroll") for (int j = 0; j < 8; ++j) { auto rr = __builtin_amdgcn_permlane32_swap(__float_as_uint(G[j]), __float_as_uint(G[j]), false, false); \
                pp[j] = __uint_as_float(rr[0]) * __uint_as_float(rr[1]); mix[j] = hi ? 1.0f : __uint_as_float(rr[1]); } \
            float P = carry; \
            _Pragma("unroll") for (int j = 7; j >= 0; --j) { \
                const float A = P * mix[j]; P *= pp[j]; \
                f32x16& bb = j < 4 ? p0 : p1; const int r = 4 * (j & 3); \
                const float t3 = A, t2 = t3 * (1.0f - bb[r + 3]), t1 = t2 * (1.0f - bb[r + 2]), t0 = t1 * (1.0f - bb[r + 1]); \
                bb[r + 3] *= t3; bb[r + 2] *= t2; bb[r + 1] *= t1; bb[r] *= t0; } \
            carry = P; \
        } \
        const v4u pw0 = (v4u){cvt_pk_bf16(p0[0], p0[1]), cvt_pk_bf16(p0[2], p0[3]), cvt_pk_bf16(p0[4], p0[5]), cvt_pk_bf16(p0[6], p0[7])}; \
        const v4u pw1 = (v4u){cvt_pk_bf16(p0[8], p0[9]), cvt_pk_bf16(p0[10], p0[11]), cvt_pk_bf16(p0[12], p0[13]), cvt_pk_bf16(p0[14], p0[15])}; \
        const v4u pw2 = (v4u){cvt_pk_bf16(p1[0], p1[1]), cvt_pk_bf16(p1[2], p1[3]), cvt_pk_bf16(p1[4], p1[5]), cvt_pk_bf16(p1[6], p1[7])}; \
        const v4u pw3 = (v4u){cvt_pk_bf16(p1[8], p1[9]), cvt_pk_bf16(p1[10], p1[11]), cvt_pk_bf16(p1[12], p1[13]), cvt_pk_bf16(p1[14], p1[15])}; \
        ATT_SBAR(); \
        pv(o, vb0 + (Lw % NS) * SLOTB, __builtin_bit_cast(bf16x8, pw0), __builtin_bit_cast(bf16x8, pw1), __builtin_bit_cast(bf16x8, pw2), __builtin_bit_cast(bf16x8, pw3)); } \
        { bool live; \
          if (FOX) live = (t > 0) && (qkb + Fb[t * KVBLK - 1] - mhat >= -fminf(150.0f, 70.0f + qkb + fminf(qkb, 30.0f)));     \
          else live = (t > 0) && (carry >= 8.6736174e-19f);     \
          const bool any_live = __any(live); \
          if (lane == 0) flags[((i) & 1) * 8 + wid] = any_live ? 1u : 0u; } }
    for (int i = 0; i < NT; i += 2) {
        ATT_STEP(pA0, pA1, pB0, pB1, i, false)
        ATT_STEP(pB0, pB1, pA0, pA1, i + 1, false)
    }
    (void)done;
#undef ATT_STEP
#undef ATT_QK
    ATT_WAIT_BAR(0);
    float rli[16];
    if (FOX) {
        { auto rr = __builtin_amdgcn_permlane32_swap(__float_as_uint(l_reg), __float_as_uint(l_reg), false, false); l_reg = __uint_as_float(rr[0]) + __uint_as_float(rr[1]); }
        if (hi == 0) wsf[32 + r32] = l_reg;
        asm volatile("s_waitcnt lgkmcnt(0)" ::: "memory");
#pragma unroll
        for (int r = 0; r < 16; ++r) rli[r] = __builtin_amdgcn_rcpf(wsf[32 + crow(r, hi)]);
    } else {
#pragma unroll
        for (int r = 0; r < 16; ++r) rli[r] = 1.0f; }
    bf16_t* Ow = qkv + (rowbase + q0 + wid * QBLK) * QP + qc + h * HD;
    { LAS bf16_t* stg = (LAS bf16_t*)(shm + LDS_OST) + wid * 2048;
#pragma unroll
      for (int r = 0; r < 16; ++r) { const int orow = crow(r, hi);
#pragma unroll
          for (int d0 = 0; d0 < 2; ++d0) stg[orow * 64 + d0 * 32 + r32] = (bf16_t)f2bf(o[d0][r] * rli[r]); }
      asm volatile("s_waitcnt lgkmcnt(0)" ::: "memory");
#pragma unroll
      for (int i = 0; i < 4; ++i) { const int row = i * 8 + (lane >> 3), ch = lane & 7; const v4u v = *(const LAS v4u*)(stg + row * 64 + ch * 8); if (dostore) *(v4u*)(Ow + (size_t)row * QP + ch * 8) = v; } }
    asm volatile("s_waitcnt lgkmcnt(0)\n\ts_barrier" ::: "memory");
#undef ATT_DMA_K
#undef ATT_DMA_V
}
}
#define XB_TMO      128
#define XB_XCNT(j)  (256  + 64 * (j))
#define XB_XSUB(j)  (1280 + 64 * (j))
#define XB_XGEN(j)  (2304 + 64 * (j))
#define XB_TOP      3328
#define XB_TOPGEN   3392
#define XB_LFLAG(j) (3456 + 64 * (j))
#define XB_XMIS     5504
#define XCD_BAR_WORDS 5568
#define XB_SPIN_CAP (1u << 18)
__device__ __forceinline__ unsigned xb_ld(unsigned* p)              { return __hip_atomic_load(p, __ATOMIC_RELAXED, __HIP_MEMORY_SCOPE_AGENT); }
__device__ __forceinline__ unsigned xb_add(unsigned* p, unsigned v) { return __hip_atomic_fetch_add(p, v, __ATOMIC_RELAXED, __HIP_MEMORY_SCOPE_AGENT); }
__device__ __forceinline__ unsigned xb_xcc_id() { return (unsigned)__builtin_amdgcn_s_getreg((3 << 11) | 20) & 0xFu; }
#define XB_SPIN(cond, bar) do { unsigned _sp = 0; while (cond) { __builtin_amdgcn_s_sleep(1); \
    if ((++_sp & 255u) == 0u) { if (xb_ld(&(bar)[XB_TMO])) break; if (_sp > XB_SPIN_CAP) { atomicAdd(&(bar)[XB_TMO], 1u); break; } } } } while (0)
struct XcdBarrier { unsigned* bar; unsigned x; volatile LAS unsigned* st; };
__device__ __forceinline__ XcdBarrier xcd_barrier_post(unsigned* bar, volatile LAS unsigned* st) {
    XcdBarrier b; b.bar = bar; b.x = xb_xcc_id(); b.st = st;
    if (threadIdx.x == 0) (void)xb_add(&bar[XB_XCNT(b.x)], 1u);
    return b;
}
__device__ __forceinline__ void xcd_barrier_complete(unsigned* bar, unsigned x, unsigned& nloc, unsigned& nx) {
    const unsigned G = gridDim.x * gridDim.y * gridDim.z;
    unsigned sum, cnt, mine, sp = 0u;
    for (;;) {
        sum = 0u; cnt = 0u; mine = 0u;
#pragma unroll
        for (unsigned j = 0; j < 16; ++j) { const unsigned c = xb_ld(&bar[XB_XCNT(j)]); sum += c; cnt += (c > 0u) ? 1u : 0u; mine = (j == x) ? c : mine; }
        if (sum == G) break;
        __builtin_amdgcn_s_sleep(1);
        if ((++sp & 255u) == 0u) { if (xb_ld(&bar[XB_TMO])) break; if (sp > XB_SPIN_CAP) { atomicAdd(&bar[XB_TMO], 1u); break; } }
    }
    nloc = mine > 0u ? mine : 1u; nx = cnt > 0u ? cnt : 1u;
}
__device__ __forceinline__ void xcd_barrier_impl(unsigned* bar_, unsigned x_, volatile LAS unsigned* st_) {
    asm volatile("" : "+s"(bar_), "+s"(x_) :: "memory");
    XcdBarrier b; b.bar = bar_; b.x = x_; b.st = st_;
    asm volatile("s_waitcnt vmcnt(0)" ::: "memory");
    __syncthreads();
    if (threadIdx.x == 0) {
        unsigned* bar = b.bar;
        __builtin_amdgcn_s_waitcnt(0);
        unsigned nloc = b.st[0], nx = b.st[1];
        if (nloc == 0u) { xcd_barrier_complete(bar, b.x, nloc, nx); b.st[0] = nloc; b.st[1] = nx; }
        const unsigned old = xb_add(&bar[XB_XSUB(b.x)], 1u);
        const unsigned gen = old / nloc;
        if (old + 1u == (gen + 1u) * nloc) {
            __builtin_amdgcn_fence(__ATOMIC_RELEASE, "agent");
            asm volatile("s_waitcnt vmcnt(0)" ::: "memory");
            const unsigned og = xb_add(&bar[XB_TOP], 1u);
            const unsigned tg = og / nx;
            if (og + 1u == (tg + 1u) * nx) xb_add(&bar[XB_TOPGEN], 1u);
            else XB_SPIN(xb_ld(&bar[XB_TOPGEN]) == tg, bar);
            __builtin_amdgcn_fence(__ATOMIC_ACQUIRE, "agent");
            xb_add(&bar[XB_XGEN(b.x)], 1u);
            asm volatile("s_waitcnt vmcnt(0)" ::: "memory");
        } else {
            XB_SPIN(xb_ld(&bar[XB_XGEN(b.x)]) == gen, bar);
            __builtin_amdgcn_fence(__ATOMIC_ACQUIRE, "agent");
            asm volatile("s_waitcnt vmcnt(0)" ::: "memory");
        }
    }
    __syncthreads();
}

__device__ __forceinline__ void xcd_local_barrier(unsigned* bar_, unsigned x_, volatile LAS unsigned* gen_) {
    asm volatile("" : "+s"(bar_), "+s"(x_) :: "memory");
    asm volatile("s_waitcnt vmcnt(0)" ::: "memory");
    __syncthreads();
    if (threadIdx.x < 64) {
        const unsigned lane_ = threadIdx.x, nl = gridDim.x >> 3, rank = blockIdx.x >> 3, gen = gen_[0] + 1u;
        unsigned* fl = bar_ + XB_LFLAG(x_);
        if (lane_ == 0) *(volatile unsigned*)(fl + rank) = gen;
        asm volatile("s_waitcnt vmcnt(0)" ::: "memory");
        unsigned sp_ = 0;
        for (;;) {
            unsigned v = gen; if (lane_ < nl) v = xb_ld(fl + lane_);
            if (__all((int)(v - gen) >= 0)) break;
            __builtin_amdgcn_s_sleep(1);
            if ((++sp_ & 1023u) == 0u) { if (xb_ld(&bar_[XB_TMO])) break; if (sp_ > (XB_SPIN_CAP << 2)) { atomicAdd(&bar_[XB_TMO], 1u); break; } }
        }
        __builtin_amdgcn_fence(__ATOMIC_ACQUIRE, "agent");
        asm volatile("s_waitcnt vmcnt(0)" ::: "memory");
        if (lane_ == 0) gen_[0] = gen;
    }
    __syncthreads();
}

constexpr int CW_ATTQ = 1024;
constexpr int CW_BAR = 4096;
constexpr int RING_BYTES = 131072, MISC_OFF = RING_BYTES + 320, LDS_BYTES = 147456;
constexpr int NPHASE = 15;
struct MkArgs { Ptrs P; int ph_lo, ph_hi, li, pad; };

#define OPAQUE_V(x) asm volatile("" : "+v"(x))
#define OPAQUE_S(x) asm volatile("" : "+s"(x))
__device__ __forceinline__ const float* ldp(LAS unsigned long long* t, int i) { const unsigned long long v = t[i];
    const unsigned lo = __builtin_amdgcn_readfirstlane((unsigned)v), hi = __builtin_amdgcn_readfirstlane((unsigned)(v >> 32)); return (const float*)(((unsigned long long)hi << 32) | lo); }
#define PHASE_BEGIN() int tid = __builtin_amdgcn_readfirstlane((int)WTAB[__builtin_amdgcn_s_getreg(0x2804)]) * 64 + (int)__builtin_amdgcn_mbcnt_hi(~0u, __builtin_amdgcn_mbcnt_lo(~0u, 0u)); asm volatile("" : "+v"(tid) :: "memory"); const int lane = tid & 63, wave = __builtin_amdgcn_readfirstlane(tid >> 6); \
    int G = gridDim.x, bx = blockIdx.x; OPAQUE_S(G); OPAQUE_S(bx); const int vcu = (G % 8 == 0) ? (bx % 8) * (G / 8) + bx / 8 : bx; const int gw = vcu * 8 + wave, ngw = G * 8; \
    Ptrs P; P.x = ldp(ptab, 0); P.g_mix = ldp(ptab, 1); P.w_in = ldp(ptab, 2); P.b_f = ldp(ptab, 3); P.b_gate = ldp(ptab, 4); P.g_q = ldp(ptab, 5); P.g_k = ldp(ptab, 6); P.w_o_sb = ldp(ptab, 7); P.w_o_fox = ldp(ptab, 8); \
    P.w_out = ldp(ptab, 9); P.g_ffn = ldp(ptab, 10); P.w_gu = ldp(ptab, 11); P.w_dn = ldp(ptab, 12); P.w_router = ldp(ptab, 13); P.w_gue = ldp(ptab, 14); P.w_dne = ldp(ptab, 15); P.out = (float*)ldp(ptab, 16); P.ws = (unsigned char*)ldp(ptab, 17); \
    unsigned char* ws = P.ws; \
    bf16_t* xb = (bf16_t*)(ws + WS_XB); bf16_t* qkv = (bf16_t*)(ws + WS_QKV); bf16_t* gates = (bf16_t*)(ws + WS_GATE); float* ssq = (float*)(ws + WS_SSQ); float* logf = (float*)(ws + WS_LOGF); \
    (void)lane; (void)wave; (void)vcu; (void)gw; (void)ngw; (void)xb; (void)qkv; (void)gates; (void)ssq; (void)logf

#ifndef ATT_TY_HI
#define ATT_TY_HI 1
#define ATT_TY_LO 0
#endif
#ifndef STAGGER_TICKS
#define STAGGER_TICKS(us) ((us) * 100)
#endif
#define STAGGER(us) do { } while (0)
#define MK_LOCALS() volatile LAS unsigned* MISC = (volatile LAS unsigned*)(lds + MISC_OFF); LAS unsigned long long* ptab = (LAS unsigned long long*)(lds + MISC_OFF + 128); \
    volatile LAS unsigned* WTAB = (volatile LAS unsigned*)(lds + RING_BYTES); (void)MISC; (void)ptab; (void)WTAB
#define PH_LO() __builtin_amdgcn_readfirstlane((int)MISC[10])
#define PH_HI() __builtin_amdgcn_readfirstlane((int)MISC[11])
#ifndef PH_EN
#define PH_EN 0x7fff
#endif
#define IN(k) (((PH_EN >> (k)) & 1) && PH_LO() <= (k) && (k) < PH_HI())
#ifndef REP_MASK
#define REP_MASK 0
#endif
#define NREP(k) (1 + ((REP_MASK >> (k)) & 1))
#define REP2(k, ...) do { { __VA_ARGS__ } if (NREP(k) > 1) { __VA_ARGS__ } } while (0)
#define SEAM(k) do { if (IN(k) && IN((k) + 1)) xcd_barrier_impl((unsigned*)ldp(ptab, 18), (unsigned)__builtin_amdgcn_readfirstlane((int)MISC[12]), MISC + 8); } while (0)
#define XLOC() __builtin_amdgcn_readfirstlane((int)MISC[13])
#ifdef SEAML2X
#define SEAM_L_EXTRA xcd_local_barrier((unsigned*)ldp(ptab, 18), (unsigned)__builtin_amdgcn_readfirstlane((int)MISC[12]), MISC + 14);
#else
#define SEAM_L_EXTRA
#endif
#define SEAM_L(k) do { if (IN(k) && IN((k) + 1)) { if (XLOC()) { xcd_local_barrier((unsigned*)ldp(ptab, 18), (unsigned)__builtin_amdgcn_readfirstlane((int)MISC[12]), MISC + 14); SEAM_L_EXTRA } else xcd_barrier_impl((unsigned*)ldp(ptab, 18), (unsigned)__builtin_amdgcn_readfirstlane((int)MISC[12]), MISC + 8); } } while (0)


template <int l> __device__ __forceinline__ void layer_phases(LAS unsigned char* lds) {
    MK_LOCALS();
    constexpr int pb = 1 + 6 * l;
        if (IN(pb)) REP2(pb, PHASE_BEGIN();
            if (l == 1) { row_pass_fill<1>(P, (LAS float*)lds, tid); asm volatile("s_waitcnt vmcnt(0) lgkmcnt(0)\n\ts_barrier" ::: "memory"); if (G % 8 == 0) row_pass<1, true>(P, (bx % 8) * (M / 8) + (bx / 8) * 8 + wave, G, lane, (LAS const float*)lds, (bx % 8 + 1) * (M / 8)); else row_pass<1, true>(P, gw, ngw, lane, (LAS const float*)lds);        asm volatile("s_waitcnt lgkmcnt(0)\n\ts_barrier" ::: "memory"); }
            { pg8::StaticOrder S; S.init((const bf16_t*)(ws + WS_WIN) + (size_t)l * NQKV * DM, M / 256, NQKV / 256, DM, G, bx);
              pg8::fill_rstd(lds, ssq, S, tid); pg8::EpiIn E{qkv, (LAS const float*)(lds + pg8::RSL_OFF), P.g_q + l * HD, P.g_k + l * HD};
              pg8::gemm_phase(lds, (const char*)xb, DM, DM, S, E, tid); }
            { pg8::StaticOrder S; S.init((const bf16_t*)((unsigned char*)(ws + WS_WG8) + (size_t)l * NGATE * DM), M / 256, NGATE / 256, DM / 2, G, bx);
              pg8::fill_rstd(lds, ssq, S, tid); pg8::EpiGate E{gates, (LAS const float*)(lds + pg8::RSL_OFF), P.b_gate + l * NGATE};
              pg8::gemm_phase<false, false, true>(lds, (const char*)P.out, DM / 2, DM / 2, S, E, tid); }
        );
        SEAM_L(pb);
        if (IN(pb + 1)) for (int rep_ = 0; rep_ < NREP(pb + 1); ++rep_) { PHASE_BEGIN(); const bool dostore = (rep_ == NREP(pb + 1) - 1);
            float gq = fabsf(P.g_q[l * HD + lane]), gk = fabsf(P.g_k[l * HD + lane]);
#pragma unroll
            for (int o = 1; o < 64; o <<= 1) { gq = fmaxf(gq, __shfl_xor(gq, o)); gk = fmaxf(gk, __shfl_xor(gk, o)); }
            const float qkb = 64.0f * gq * gk * C2 * 1.02f;
            unsigned* qctr = (unsigned*)(ws + WS_CTL) + CW_ATTQ + 128 * l + 256 * rep_;
            volatile LAS int* qs = (volatile LAS int*)(lds + MISC_OFF + 64);
            const int xl = XLOC();
            const int nunit = xl ? NH * 16 : BATCH * NH * 16;
#pragma unroll
            for (int ty = ATT_TY_HI; ty >= ATT_TY_LO; --ty) {
                unsigned* ctr = qctr + 64 * ty + (xl ? 8 * (bx % 8) : 0); int par = 0;
                if (tid == 0) qs[0] = (int)atomicAdd(ctr, 1u);
                asm volatile("s_waitcnt vmcnt(0) lgkmcnt(0)\n\ts_barrier" ::: "memory");
                int u = qs[0];
                while (u < nunit) {
                    int pre = 0; if (tid == 0) pre = (int)atomicAdd(ctr, 1u);
                    const int qb = 15 - (xl ? (u >> 3) : (u >> 6)), bh = xl ? (bx % 8) * NH + (u & 7) : (u & 63);
                    if (ty) attn::attn_unit<1>(bh / NH, bh % NH, qb, qkv, logf, (LAS char*)lds, tid, qkb, dostore); else attn::attn_unit<0>(bh / NH, bh % NH, qb, qkv, logf, (LAS char*)lds, tid, qkb, dostore);
                    par ^= 1; if (tid == 0) qs[par] = pre;
                    asm volatile("s_waitcnt vmcnt(0) lgkmcnt(0)\n\ts_barrier" ::: "memory");
                    u = qs[par];
                }
            }
        }
        SEAM_L(pb + 1);
        if (IN(pb + 2)) REP2(pb + 2, PHASE_BEGIN();
            pg8::StaticOrder S; S.init((const bf16_t*)(ws + WS_WOSB) + (size_t)l * DM * DM, M / 256, DM / 256, DM, G, bx); pg8::EpiOM E{qkv, gates};
            pg8::gemm_phase<false, true>(lds, (const char*)qkv, QP, DM, S, E, tid, 8, (size_t)(1536 - 512) * 2);
        );
        SEAM_L(pb + 2);
        if (IN(pb + 3)) REP2((l == 0 ? pb + 3 : 31), PHASE_BEGIN();
            pg8::StaticOrder S; S.init((const bf16_t*)(ws + WS_WOUT) + (size_t)l * DM * DM, M / 256, DM / 256, DM, G, bx);
            if (l == 0) { pg8::EpiResT<true> E{P.x, xb, ssq, nullptr, 1.0f}; pg8::gemm_phase(lds, (const char*)(qkv + 512), QP, DM, S, E, tid); }
            else { pg8::EpiResT<false> E{xb, xb, ssq, nullptr, 1.0f}; pg8::gemm_phase(lds, (const char*)(qkv + 512), QP, DM, S, E, tid); }
        );
        SEAM_L(pb + 3);
        if (l == 0) {
            if (IN(5)) REP2(5, PHASE_BEGIN(); pg8::StaticOrder S; S.init((const bf16_t*)(ws + WS_WGU), M / 256, 2 * DFF / 256, DM, G, bx); pg8::fill_rstd(lds, ssq, S, tid); pg8::EpiUp E{(unsigned char*)qkv, (LAS const float*)(lds + pg8::RSL_OFF)}; STAGGER(9); pg8::gemm_phase(lds, (const char*)xb, DM, DM, S, E, tid); );
            SEAM_L(5);
            if (IN(6)) { PHASE_BEGIN(); pg8::StaticOrder S; S.init((const bf16_t*)(ws + WS_WDN), M / 256, DM / 256, DFF / 2, G, bx); pg8::EpiResT<false, true> E{xb, xb, ssq, (unsigned char*)P.out, DN_INV}; pg8::gemm_phase<false, false, true>(lds, (const char*)qkv, DFF / 2, DFF / 2, S, E, tid);     }
            SEAM_L(6);
        }
    }

__global__ void __launch_bounds__(512, 2) mk_fwd(MkArgs args) {
    extern __shared__ __attribute__((aligned(16))) unsigned char lds_raw[];
    LAS unsigned char* lds = (LAS unsigned char*)lds_raw;
    MK_LOCALS();
    for (int u = threadIdx.x; u < (LDS_BYTES - RING_BYTES) / 4; u += 512) ((LAS unsigned*)(lds + RING_BYTES))[u] = 0u;
    __syncthreads();
    if ((threadIdx.x & 63) == 0) WTAB[__builtin_amdgcn_s_getreg(0x2804)] = threadIdx.x >> 6;
    if (threadIdx.x == 0) { const Ptrs& A = args.P;
        ptab[0] = (unsigned long long)A.x; ptab[1] = (unsigned long long)A.g_mix; ptab[2] = (unsigned long long)A.w_in; ptab[3] = (unsigned long long)A.b_f; ptab[4] = (unsigned long long)A.b_gate; ptab[5] = (unsigned long long)A.g_q;
        ptab[6] = (unsigned long long)A.g_k; ptab[7] = (unsigned long long)A.w_o_sb; ptab[8] = (unsigned long long)A.w_o_fox; ptab[9] = (unsigned long long)A.w_out; ptab[10] = (unsigned long long)A.g_ffn; ptab[11] = (unsigned long long)A.w_gu;
        ptab[12] = (unsigned long long)A.w_dn; ptab[13] = (unsigned long long)A.w_router; ptab[14] = (unsigned long long)A.w_gue; ptab[15] = (unsigned long long)A.w_dne; ptab[16] = (unsigned long long)A.out; ptab[17] = (unsigned long long)A.ws;
        ptab[18] = (unsigned long long)((unsigned*)(A.ws + WS_CTL) + CW_BAR + args.li * XCD_BAR_WORDS); MISC[10] = (unsigned)args.ph_lo; MISC[11] = (unsigned)args.ph_hi; MISC[12] = xb_xcc_id(); }
    __syncthreads();
    if (threadIdx.x == 0 && xb_xcc_id() != (blockIdx.x & 7u)) { (void)xb_add((unsigned*)(args.P.ws + WS_CTL) + CW_BAR + args.li * XCD_BAR_WORDS + XB_XMIS, 1u); asm volatile("s_waitcnt vmcnt(0)" ::: "memory"); }
    (void)xcd_barrier_post((unsigned*)(args.P.ws + WS_CTL) + CW_BAR + args.li * XCD_BAR_WORDS, MISC + 8);
    if (IN(0)) REP2(0, PHASE_BEGIN();
        LAS float* scr = (LAS float*)(lds + wave * 16384);
        for (int it = gw; it < CONV_ITEMS; it += 2 * ngw) {
            int r0_, r1_ = 0; const int j0 = conv_find(it, r0_); const ConvJob c0 = conv_job(P, j0); f32x4 v0[8], v1[8]; conv_load(c0, r0_, lane, v0);
            const bool two = it + ngw < CONV_ITEMS; int j1 = 0; if (two) j1 = conv_find(it + ngw, r1_); const ConvJob c1 = conv_job(P, j1); if (two) conv_load(c1, r1_, lane, v1);
            conv_finish(c0, r0_, scr, lane, v0); if (two) conv_finish(c1, r1_, scr, lane, v1);
        }
        asm volatile("s_waitcnt lgkmcnt(0)\n\ts_barrier" ::: "memory");
        row_pass_fill<0>(P, (LAS float*)lds, tid);
        asm volatile("s_waitcnt vmcnt(0) lgkmcnt(0)\n\ts_barrier" ::: "memory");
        row_pass<0, true>(P, gw, ngw, lane, (LAS const float*)lds);
    );
    SEAM(0);
    if (threadIdx.x == 0) MISC[13] = (gridDim.x % 8 == 0 && xb_ld((unsigned*)ldp(ptab, 18) + XB_XMIS) == 0u) ? 1u : 0u;
    __syncthreads();
    layer_phases<0>(lds);
    layer_phases<1>(lds);
    if (IN(11)) { PHASE_BEGIN(); row_pass_fill<2>(P, (LAS float*)lds, tid); asm volatile("s_waitcnt vmcnt(0) lgkmcnt(0)\n\ts_barrier" ::: "memory"); if (G % 8 == 0) row_pass<2, true>(P, (bx % 8) * (M / 8) + (bx / 8) * 8 + wave, G, lane, (LAS const float*)lds, (bx % 8 + 1) * (M / 8)); else row_pass<2, true>(P, gw, ngw, lane, (LAS const float*)lds); }
    SEAM(11);
    if (IN(12)) REP2(12, PHASE_BEGIN(); pg8::MoeOrder S; S.init(ws, (const bf16_t*)(ws + WS_WGUE), (size_t)2 * DFE * DM * 2, 2 * DFE / 256, DM, G, bx, 1);
        pg8::fill_rstd_moe(lds, (const float*)(ws + WS_RPOS), S, tid); pg8::EpiMoeUp E{(unsigned char*)qkv, (LAS const float*)(lds + pg8::RSL_OFF)}; STAGGER(9); pg8::gemm_phase(lds, (const char*)xb, DM, DM, S, E, tid); );
    SEAM(12);
    if (IN(13)) REP2(13, PHASE_BEGIN(); pg8::MoeOrder S; S.init(ws, (const bf16_t*)(ws + WS_WDNE), (size_t)DM * DFE8, DM / 256, DFE8 / 2, G, bx, 0);
        pg8::EpiMoeDn E{gates, (const float*)(ws + WS_WPOS), (const int*)(ws + WS_LIST)}; pg8::gemm_phase<false, false, true>(lds, (const char*)qkv, DFE8 / 2, DFE8 / 2, S, E, tid); );
    SEAM(13);
    if (IN(14)) { PHASE_BEGIN();
        const size_t stride = (size_t)G * 512 * 4;
        for (size_t i0 = ((size_t)bx * 512 + tid) * 4; i0 < (size_t)M * DM; i0 += 4 * stride) {
            unsigned long long xa[4], ya[4], yb[4];
#pragma unroll
            for (int q = 0; q < 4; ++q) { const size_t i = i0 + q * stride; if (i < (size_t)M * DM) { const size_t m = i / DM, c = i % DM; const bf16_t* y = gates + m * 2 * DM + c;
                xa[q] = *(const unsigned long long*)(xb + i); ya[q] = *(const unsigned long long*)y; yb[q] = *(const unsigned long long*)(y + DM); } }
#pragma unroll
            for (int q = 0; q < 4; ++q) { const size_t i = i0 + q * stride; if (i < (size_t)M * DM) { const unsigned long long x_ = xa[q], a = ya[q], b = yb[q]; f32x4 v;
                v.x = bflo((unsigned)x_) + (bflo((unsigned)a) + bflo((unsigned)b)); v.y = bfhi((unsigned)x_) + (bfhi((unsigned)a) + bfhi((unsigned)b));
                v.z = bflo((unsigned)(x_ >> 32)) + (bflo((unsigned)(a >> 32)) + bflo((unsigned)(b >> 32))); v.w = bfhi((unsigned)(x_ >> 32)) + (bfhi((unsigned)(a >> 32)) + bfhi((unsigned)(b >> 32)));
                *(f32x4*)(P.out + i) = v; } }
        }
    }
}
extern "C" void kernel_launch(void* const* d_in, const int* in_sizes, int n_in, void* d_out, int out_size, void* d_ws, size_t ws_size, hipStream_t stream) {
    if (n_in != 16 || out_size != M * DM || ws_size < WS_END) { fprintf(stderr, "kernel_launch: unexpected shapes n_in %d out %d ws %zu (need %zu)\n", n_in, out_size, ws_size, (size_t)WS_END); return; }
    static int grid = 0;
    if (grid == 0) {
        int dev = 0, cus = 0;
        if (hipGetDevice(&dev) != hipSuccess || hipDeviceGetAttribute(&cus, hipDeviceAttributeMultiprocessorCount, dev) != hipSuccess) { fprintf(stderr, "kernel_launch: device query failed\n"); grid = -1; return; }
        if (hipFuncSetAttribute((const void*)mk_fwd, hipFuncAttributeMaxDynamicSharedMemorySize, LDS_BYTES) != hipSuccess) { fprintf(stderr, "kernel_launch: hipFuncSetAttribute failed\n"); grid = -1; return; }
        int per_cu = 0; if (hipOccupancyMaxActiveBlocksPerMultiprocessor(&per_cu, (const void*)mk_fwd, 512, LDS_BYTES) != hipSuccess || per_cu < 1) fprintf(stderr, "kernel_launch: occupancy query reports %d\n", per_cu);
        (void)hipGetLastError();
        grid = cus;
    }
    if (grid < 0) return;
    Ptrs P{};
    P.x = (const float*)d_in[0]; P.g_mix = (const float*)d_in[1]; P.w_in = (const float*)d_in[2]; P.b_f = (const float*)d_in[3]; P.b_gate = (const float*)d_in[4];
    P.g_q = (const float*)d_in[5]; P.g_k = (const float*)d_in[6]; P.w_o_sb = (const float*)d_in[7]; P.w_o_fox = (const float*)d_in[8]; P.w_out = (const float*)d_in[9];
    P.g_ffn = (const float*)d_in[10]; P.w_gu = (const float*)d_in[11]; P.w_dn = (const float*)d_in[12]; P.w_router = (const float*)d_in[13]; P.w_gue = (const float*)d_in[14]; P.w_dne = (const float*)d_in[15];
    P.out = (float*)d_out; P.ws = (unsigned char*)d_ws;
    (void)hipMemsetAsync((char*)d_ws + WS_CTL, 0, CTL_BYTES, stream);
    MkArgs a{}; a.P = P; a.ph_lo = 0; a.ph_hi = NPHASE; a.li = 0; a.pad = 0;
    hipLaunchKernelGGL(mk_fwd, dim3(grid), dim3(512), LDS_BYTES, stream, a);
}
```
